# Optimizing an MI355X kernel written in HIP

```python
import jax, jax.numpy as jnp
from jax import lax
import numpy as np

D_MODEL = 2048
BATCH = 2
SEQ = 4096
DEPTH = 1

POOL_WIDTH = D_MODEL // 2
POOL_WINDOWS = (2, 4, 8, 16)
N_POOL_GROUPS = len(POOL_WINDOWS)
POOL_GROUP_DIM = POOL_WIDTH // N_POOL_GROUPS
HGRN_WIDTH = D_MODEL - POOL_WIDTH
HGRN_DK = 128
HGRN_HEADS = HGRN_WIDTH // HGRN_DK
HGRN_DV = HGRN_WIDTH // HGRN_HEADS
HGRN_KEY_WIDTH = HGRN_HEADS * HGRN_DK
CHUNK = 64
IN_COLS = POOL_WIDTH + 2 * HGRN_KEY_WIDTH + 2 * HGRN_WIDTH
D_FF = 5632
CONV_WIDTH = 3
ALPHA = (2.0 * DEPTH) ** 0.25
BETA = (8.0 * DEPTH) ** -0.25
LN_EPS = 1e-5
RMS_EPS = 1e-6

kernel_name = "hymba_pool_hgrn2_convffn_deepnorm"


def layer_norm(x, g, b):
    x32 = x.astype(jnp.float32)
    mu = jnp.mean(x32, axis=-1, keepdims=True)
    var = jnp.mean(jnp.square(x32 - mu), axis=-1, keepdims=True)
    y = (x32 - mu) * lax.rsqrt(var + LN_EPS) * g.astype(jnp.float32) + b.astype(jnp.float32)
    return y.astype(x.dtype)


def pool_mixer(u, pool_w, pool_b, pool_scale):
    B, S, _ = u.shape
    u32 = u.astype(jnp.float32).reshape(B, S, N_POOL_GROUPS, POOL_GROUP_DIM)
    cs = jnp.cumsum(u32, axis=1)
    pos = jnp.arange(S)
    pooled = []
    for gi, w in enumerate(POOL_WINDOWS):
        c = cs[:, :, gi]
        c_prev = jnp.pad(c, ((0, 0), (w, 0), (0, 0)))[:, :S]
        cnt = jnp.minimum(pos + 1, w).astype(jnp.float32)[None, :, None]
        pooled.append((c - c_prev) / cnt)
    pooled = jnp.stack(pooled, axis=2) - u32
    y = jnp.einsum('bsgc,gcd->bsgd', pooled.astype(u.dtype), pool_w) + pool_b
    return y.reshape(B, S, POOL_WIDTH) * pool_scale


def hgrn2_mixer(q, f_logit, v, gate, lb, g_norm):
    B, S, _ = q.shape
    H, dk, dv, C = HGRN_HEADS, HGRN_DK, HGRN_DV, CHUNK
    n_chunks = S // C
    lb32 = lb.astype(jnp.float32)
    f = lb32 + (1.0 - lb32) * jax.nn.sigmoid(f_logit.astype(jnp.float32))
    log_f = jnp.log(f)
    k = 1.0 - f

    def to_chunks(t, d):
        return t.astype(jnp.float32).reshape(B, n_chunks, C, H, d).transpose(1, 0, 3, 2, 4)

    qc, kc, gc, vc = to_chunks(q, dk), to_chunks(k, dk), to_chunks(log_f, dk), to_chunks(v, dv)
    causal = jnp.tril(jnp.ones((C, C), dtype=bool))[:, :, None]

    def step(state, inp):
        qt, kt, gt, vt = inp
        b = jnp.cumsum(gt, axis=-2)
        o_inter = jnp.einsum('bhck,bhkv->bhcv', qt * jnp.exp(b), state)
        diff = b[:, :, :, None, :] - b[:, :, None, :, :]
        decay = jnp.exp(jnp.where(causal, diff, -jnp.inf))
        scores = jnp.einsum('bhtk,bhsk,bhtsk->bhts', qt, kt, decay)
        o_intra = jnp.einsum('bhts,bhsv->bhtv', scores, vt)
        b_last = b[:, :, -1:, :]
        new_state = (jnp.exp(b_last[:, :, 0, :])[..., None] * state
                     + jnp.einsum('bhsk,bhsv->bhkv', kt * jnp.exp(b_last - b), vt))
        return new_state, o_inter + o_intra

    s0 = jnp.zeros((B, H, dk, dv), jnp.float32)
    _, o = lax.scan(step, s0, (qc, kc, gc, vc))
    o = o.transpose(1, 0, 3, 2, 4).reshape(B, S, H, dv)
    o = o * lax.rsqrt(jnp.mean(jnp.square(o), axis=-1, keepdims=True) + RMS_EPS)
    o = o.reshape(B, S, H * dv) * g_norm.astype(jnp.float32)
    o = o * jax.nn.silu(gate.astype(jnp.float32))
    return o.astype(q.dtype)


def conv_ffn(h, w_up, conv_w, conv_b, w_down):
    S = h.shape[1]
    u = h @ w_up
    up = jnp.pad(u, ((0, 0), (CONV_WIDTH - 1, 0), (0, 0)))
    uc = conv_b + sum(conv_w[j] * up[:, j:j + S] for j in range(CONV_WIDTH))
    g, val = jnp.split(uc, 2, axis=-1)
    return (jax.nn.silu(g) * val) @ w_down


def setup_inputs(seed: int = 0) -> dict:
    key = jax.random.key(seed)
    ks = jax.random.split(key, 20)
    L = DEPTH
    nrm = lambda k, shape: jax.random.normal(k, shape, jnp.float32)
    return {
        "x": nrm(ks[0], (BATCH, SEQ, D_MODEL)),
        "w_in": nrm(ks[1], (L, D_MODEL, IN_COLS)) * D_MODEL ** -0.5,
        "pool_w": nrm(ks[2], (L, N_POOL_GROUPS, POOL_GROUP_DIM, POOL_GROUP_DIM)) * POOL_GROUP_DIM ** -0.5,
        "pool_b": 0.02 * nrm(ks[3], (L, N_POOL_GROUPS, POOL_GROUP_DIM)),
        "pool_scale": 1.0 + 0.1 * nrm(ks[4], (L, POOL_WIDTH)),
        "hgrn_lb_logits": 1.0 + 0.5 * nrm(ks[5], (L + 1, HGRN_KEY_WIDTH)),
        "hgrn_g_norm": 1.0 + 0.02 * nrm(ks[6], (L, HGRN_WIDTH)),
        "w_out": nrm(ks[7], (L, D_MODEL, D_MODEL)) * D_MODEL ** -0.5 * BETA,
        "ln1_g": 1.0 + 0.02 * nrm(ks[8], (L, D_MODEL)),
        "ln1_b": 0.02 * nrm(ks[9], (L, D_MODEL)),
        "w_up": nrm(ks[10], (L, D_MODEL, 2 * D_FF)) * D_MODEL ** -0.5,
        "conv_w": nrm(ks[11], (L, CONV_WIDTH, 2 * D_FF)) * CONV_WIDTH ** -0.5,
        "conv_b": 0.02 * nrm(ks[12], (L, 2 * D_FF)),
        "w_down": nrm(ks[13], (L, D_FF, D_MODEL)) * D_FF ** -0.5 * BETA,
        "ln2_g": 1.0 + 0.02 * nrm(ks[14], (L, D_MODEL)),
        "ln2_b": 0.02 * nrm(ks[15], (L, D_MODEL)),
    }


def reference(x, w_in, pool_w, pool_b, pool_scale, hgrn_lb_logits, hgrn_g_norm, w_out,
              ln1_g, ln1_b, w_up, conv_w, conv_b, w_down, ln2_g, ln2_b):
    lb_all = jnp.cumsum(jax.nn.softmax(hgrn_lb_logits.astype(jnp.float32), axis=0), axis=0)
    for l in range(DEPTH):
        proj = x @ w_in[l]
        o1 = POOL_WIDTH
        o2 = o1 + HGRN_KEY_WIDTH
        o3 = o2 + HGRN_KEY_WIDTH
        o4 = o3 + HGRN_WIDTH
        u_pool = proj[..., :o1]
        q, f_logit, v, gate = proj[..., o1:o2], proj[..., o2:o3], proj[..., o3:o4], proj[..., o4:]
        a_out = pool_mixer(u_pool, pool_w[l], pool_b[l], pool_scale[l])
        b_out = hgrn2_mixer(q, f_logit, v, gate, lb_all[l], hgrn_g_norm[l])
        mix = jnp.concatenate([a_out, b_out], axis=-1) @ w_out[l]
        x = layer_norm(ALPHA * x + mix, ln1_g[l], ln1_b[l])
        x = layer_norm(ALPHA * x + conv_ffn(x, w_up[l], conv_w[l], conv_b[l], w_down[l]), ln2_g[l], ln2_b[l])
    return x
```

```cpp
#include <hip/hip_runtime.h>
#include <hip/hip_cooperative_groups.h>
#include <cstdio>
#include <cstdint>
namespace cg = cooperative_groups;
namespace pg8 {
#define PG8_LAS __attribute__((address_space(3)))
typedef unsigned short bf16_t;
typedef short bf16x8 __attribute__((ext_vector_type(8)));
typedef float f32x4 __attribute__((ext_vector_type(4)));
typedef unsigned u32x4 __attribute__((ext_vector_type(4)));
constexpr int BM = 256, BK = 64, HALF = 128, HTB = HALF * BK * 2  , STAGE_BYTES = 8 * HTB, NXCD = 8, WGM = 8;

__host__ __device__ __forceinline__ int lds_byte(int r, int c) { const int st = (r >> 4) * 2 + (c >> 5), rr = r & 15, cc = c & 31, ob = rr * 64 + cc * 2; return st * 1024 + (ob ^ (((ob >> 9) & 1) << 5)); }
__host__ __device__ __forceinline__ void stage_rc(int b, int& R, int& C) { const int st = b / 1024, sb = b % 1024, swz = sb ^ (((sb >> 9) & 1) << 5); R = (st >> 1) * 16 + swz / 64; C = (st & 1) * 32 + (swz % 64) / 2; }
__host__ __device__ __forceinline__ int perm32(int rho) { const int n = rho >> 4, i = rho & 15; return 8 * (i >> 2) + 4 * n + (i & 3); }

struct Unit { int pm, pn; };
struct Gemm { const bf16_t* A; const bf16_t* Bt; int M, N, K, lda, apn; };

struct StaticOrder {
    int nM, nN, nwg, G, c;
    __host__ __device__ void init(int M, int N, int G_, int c_) { nM = M / BM; nN = N / BM; nwg = nM * nN; G = G_; c = c_; }
    __host__ __device__ bool next(int i, Unit& u) const {
        const long L = (long)i * G + c; if (L >= nwg) return false;
        int wgid = (int)L; { const int q = nwg / NXCD, r = nwg % NXCD, xcd = wgid % NXCD, off = wgid / NXCD; wgid = (xcd < r ? xcd * (q + 1) : r * (q + 1) + (xcd - r) * q) + off; }
        const int nig = WGM * nN, gid = wgid / nig, fm = gid * WGM, gsz = (nM - fm) < WGM ? (nM - fm) : WGM;
        u.pm = fm + ((wgid % nig) % gsz); u.pn = (wgid % nig) / gsz; return true;
    }
    __device__ __forceinline__ void a_ready(const Unit&) const {}
    __device__ __forceinline__ void done(const Unit&) const {}
};

__device__ __forceinline__ unsigned cvt_pk_bf16(float lo, float hi) { unsigned r; asm volatile("v_cvt_pk_bf16_f32 %0, %1, %2" : "=v"(r) : "v"(lo), "v"(hi)); return r; }
typedef float f32x2 __attribute__((ext_vector_type(2)));
template <class Epi, class Sched, bool ALIGN_EPI = false, bool SP2 = false>
__device__ __forceinline__ void gemm_phase(PG8_LAS unsigned char* lds, const Gemm g, const Sched& S, const Epi& E) {
    const int tid = threadIdx.x, wid = __builtin_amdgcn_readfirstlane(tid >> 6), lane = tid & 63, wr = wid >> 2, wc = wid & 3, fr = lane & 15, fq = lane >> 4;
    const int K = g.K, nt = K / BK;
    unsigned voffA[2], voffB[2];
#pragma unroll
    for (int i = 0; i < 2; ++i) { int R, C; stage_rc(tid * 16 + i * 8192, R, C); const int Rb = Epi::PERM ? ((R & ~31) + perm32(R & 31)) : R;
        voffA[i] = (unsigned)(R * g.lda + C) * 2u; voffB[i] = (unsigned)(Rb * K + C) * 2u; }
    const size_t kstep = (size_t)(BK * 2);
    const size_t hstepA = (size_t)HALF * g.lda * 2, hstepB = (size_t)HALF * K * 2;
    const size_t tstepA = 2 * hstepA, tstepB = 2 * hstepB, apnb = (size_t)g.apn * 2;
    const unsigned ldsw = (unsigned)wid * 1024u;
    const int aoff = lds_byte(wr * 64 + fr, fq * 8), boff = lds_byte(wc * 32 + fr, fq * 8);
#define PG8_SA(b, h) (((b) * 2 + (h)) * HTB)
#define PG8_SB(b, h) ((4 + (b) * 2 + (h)) * HTB)
#define PG8_STAGE(bufoff, gbase, voff) do { _Pragma("unroll") for (int _i = 0; _i < 2; ++_i) \
        __builtin_amdgcn_global_load_lds((const unsigned*)((const char*)(gbase) + (voff)[_i]), (PG8_LAS unsigned*)(lds + (bufoff) + ldsw + _i * 8192), 16, 0, 0); } while (0)
#define PG8_LDA(dst, b, h) do { _Pragma("unroll") for (int m = 0; m < 4; ++m) _Pragma("unroll") for (int k = 0; k < 2; ++k) dst[m][k] = *(const PG8_LAS bf16x8*)(lds + PG8_SA(b, h) + aoff + m * 2048 + k * 1024); } while (0)
#define PG8_LDB(dst, b, h) do { _Pragma("unroll") for (int n = 0; n < 2; ++n) _Pragma("unroll") for (int k = 0; k < 2; ++k) dst[n][k] = *(const PG8_LAS bf16x8*)(lds + PG8_SB(b, h) + boff + n * 2048 + k * 1024); } while (0)
#define PG8_MMA(ai, bj, At, Bt) do { __builtin_amdgcn_s_setprio(1); _Pragma("unroll") for (int m = 0; m < 4; ++m) _Pragma("unroll") for (int n = 0; n < 2; ++n) _Pragma("unroll") for (int k = 0; k < 2; ++k) \
        acc[ai][bj][m][n] = __builtin_amdgcn_mfma_f32_16x16x32_bf16(Bt[n][k], At[m][k], acc[ai][bj][m][n], 0, 0, 0); __builtin_amdgcn_s_setprio(0); } while (0)
#define PG8_WAIT_V(n) asm volatile("s_waitcnt vmcnt(" #n ")" ::: "memory")
#define PG8_WAIT_L(n) asm volatile("s_waitcnt lgkmcnt(" #n ")" ::: "memory")
#define PG8_BAR __builtin_amdgcn_s_barrier()
#define PG8_SCHED __builtin_amdgcn_sched_barrier(0)
    Unit cur, nxt; int ui = 0;
    if (!S.next(0, cur)) return;
    f32x4 acc[2][2][4][2];
#pragma unroll
    for (int a = 0; a < 2; ++a)
#pragma unroll
        for (int b = 0; b < 2; ++b)
#pragma unroll
            for (int m = 0; m < 4; ++m)
#pragma unroll
                for (int n = 0; n < 2; ++n) acc[a][b][m][n] = (f32x4){0.f, 0.f, 0.f, 0.f};
    bf16x8 At[4][2], B0[2][2], B1[2][2];
    const char* cA = (const char*)g.A + (size_t)cur.pm * tstepA + (size_t)cur.pn * apnb; const char* cB = (const char*)g.Bt + (size_t)cur.pn * tstepB;
    S.a_ready(cur);
    if constexpr (SP2) {
        PG8_STAGE(PG8_SB(0, 0), cB, voffB); PG8_STAGE(PG8_SB(0, 1), cB + hstepB, voffB); PG8_STAGE(PG8_SA(0, 0), cA, voffA); PG8_STAGE(PG8_SA(0, 1), cA + hstepA, voffA);
        if (wr == 1) PG8_BAR;
        PG8_WAIT_V(2); PG8_BAR;
        PG8_STAGE(PG8_SB(1, 0), cB + kstep, voffB); PG8_STAGE(PG8_SA(1, 0), cA + kstep, voffA); PG8_STAGE(PG8_SB(1, 1), cB + hstepB + kstep, voffB);
        PG8_WAIT_V(6); PG8_BAR;
    } else {
        PG8_STAGE(PG8_SB(0, 0), cB, voffB); PG8_STAGE(PG8_SA(0, 0), cA, voffA); PG8_STAGE(PG8_SB(0, 1), cB + hstepB, voffB); PG8_STAGE(PG8_SA(0, 1), cA + hstepA, voffA);
        if (wr == 1) PG8_BAR;
        PG8_WAIT_V(4); PG8_BAR;
        PG8_STAGE(PG8_SB(1, 0), cB + kstep, voffB); PG8_STAGE(PG8_SA(1, 0), cA + kstep, voffA); PG8_STAGE(PG8_SB(1, 1), cB + hstepB + kstep, voffB);
        PG8_WAIT_V(6); PG8_BAR;
    }
    for (;;) {
        const bool has_next = S.next(ui + 1, nxt);
        const char* nA = has_next ? (const char*)g.A + (size_t)nxt.pm * tstepA + (size_t)nxt.pn * apnb : cA; const char* nB = has_next ? (const char*)g.Bt + (size_t)nxt.pn * tstepB : cB;
        for (int t = 0; t < nt; t += 2) {
            const bool last = (t == nt - 2);
            const char* a1 = cA + (size_t)(t + 1) * kstep;
            const char* a2 = last ? nA : cA + (size_t)(t + 2) * kstep; const char* b2 = last ? nB : cB + (size_t)(t + 2) * kstep;
            const char* a3 = a2 + kstep; const char* b3 = b2 + kstep;
            if (last && has_next) S.a_ready(nxt);
            if constexpr (SP2) {
            PG8_LDB(B0, 0, 0); PG8_LDB(B1, 0, 1); PG8_SCHED; PG8_LDA(At, 0, 0); PG8_STAGE(PG8_SA(1, 1), a1 + hstepA, voffA);
            PG8_WAIT_V(8); PG8_WAIT_L(0); PG8_BAR; PG8_MMA(0, 0, At, B0); PG8_MMA(0, 1, At, B1); PG8_BAR; PG8_SCHED;
            PG8_LDA(At, 0, 1); PG8_STAGE(PG8_SB(0, 0), b2, voffB); PG8_STAGE(PG8_SB(0, 1), b2 + hstepB, voffB); PG8_STAGE(PG8_SA(0, 0), a2, voffA);
            PG8_WAIT_V(8); PG8_WAIT_L(0); PG8_BAR; PG8_MMA(1, 0, At, B0); PG8_MMA(1, 1, At, B1); PG8_BAR; PG8_SCHED;
            PG8_LDB(B0, 1, 0); PG8_LDB(B1, 1, 1); PG8_SCHED; PG8_LDA(At, 1, 0); PG8_STAGE(PG8_SA(0, 1), a2 + hstepA, voffA);
            PG8_WAIT_V(8); PG8_WAIT_L(0); PG8_BAR; PG8_MMA(0, 0, At, B0); PG8_MMA(0, 1, At, B1); PG8_BAR; PG8_SCHED;
            PG8_LDA(At, 1, 1); PG8_STAGE(PG8_SB(1, 0), b3, voffB); PG8_STAGE(PG8_SB(1, 1), b3 + hstepB, voffB); PG8_STAGE(PG8_SA(1, 0), a3, voffA);
            PG8_WAIT_V(8); PG8_WAIT_L(0); PG8_BAR; PG8_MMA(1, 0, At, B0); PG8_MMA(1, 1, At, B1); PG8_BAR; PG8_SCHED;
            } else {
            PG8_LDB(B0, 0, 0); PG8_SCHED; PG8_LDA(At, 0, 0); PG8_STAGE(PG8_SA(1, 1), a1 + hstepA, voffA);
            PG8_WAIT_L(8); PG8_BAR; PG8_WAIT_L(0); PG8_MMA(0, 0, At, B0); PG8_BAR; PG8_SCHED;
            PG8_LDB(B1, 0, 1); PG8_STAGE(PG8_SB(0, 0), b2, voffB);
            PG8_BAR; PG8_WAIT_L(0); PG8_MMA(0, 1, At, B1); PG8_BAR;
            PG8_LDA(At, 0, 1); PG8_STAGE(PG8_SA(0, 0), a2, voffA);
            PG8_BAR; PG8_WAIT_L(0); PG8_MMA(1, 0, At, B0); PG8_BAR; PG8_SCHED;
            PG8_STAGE(PG8_SB(0, 1), b2 + hstepB, voffB);
            PG8_WAIT_V(6); PG8_BAR; PG8_MMA(1, 1, At, B1); PG8_BAR;
            PG8_LDB(B0, 1, 0); PG8_SCHED; PG8_LDA(At, 1, 0); PG8_STAGE(PG8_SA(0, 1), a2 + hstepA, voffA);
            PG8_WAIT_L(8); PG8_BAR; PG8_WAIT_L(0); PG8_MMA(0, 0, At, B0); PG8_BAR; PG8_SCHED;
            PG8_LDB(B1, 1, 1); PG8_STAGE(PG8_SB(1, 0), b3, voffB);
            PG8_BAR; PG8_WAIT_L(0); PG8_MMA(0, 1, At, B1); PG8_BAR;
            PG8_LDA(At, 1, 1); PG8_STAGE(PG8_SA(1, 0), a3, voffA);
            PG8_BAR; PG8_WAIT_L(0); PG8_MMA(1, 0, At, B0); PG8_BAR; PG8_SCHED;
            PG8_STAGE(PG8_SB(1, 1), b3 + hstepB, voffB);
            PG8_WAIT_V(6); PG8_BAR; PG8_MMA(1, 1, At, B1); PG8_BAR;
            }
        }
        if constexpr (ALIGN_EPI) { if (wr == 0) PG8_BAR; }
        if constexpr (!Epi::AFTER_DRAIN) { E(acc, cur, wr, wc, fr, fq); S.done(cur); }
        if (!has_next) break;
#pragma unroll
        for (int a = 0; a < 2; ++a)
#pragma unroll
            for (int b = 0; b < 2; ++b)
#pragma unroll
                for (int m = 0; m < 4; ++m)
#pragma unroll
                    for (int n = 0; n < 2; ++n) acc[a][b][m][n] = (f32x4){0.f, 0.f, 0.f, 0.f};
        cur = nxt; cA = nA; cB = nB; ++ui;
        if constexpr (ALIGN_EPI) { if (wr == 1) PG8_BAR; }
    }
    PG8_WAIT_V(0);
    if constexpr (!ALIGN_EPI) { if (wr == 0) PG8_BAR; }
    PG8_BAR;
    if constexpr (Epi::AFTER_DRAIN) { E.fused(acc, cur, wr, wc, fr, fq, lds, wid, lane); S.done(cur); }
#undef PG8_SA
#undef PG8_SB
#undef PG8_STAGE
#undef PG8_LDA
#undef PG8_LDB
#undef PG8_MMA
#undef PG8_WAIT_V
#undef PG8_WAIT_L
#undef PG8_BAR
#undef PG8_SCHED
}
}
namespace pg8 {
__device__ __forceinline__ float sigmoidf_(float x) { return 1.0f / (1.0f + __expf(-x)); }
struct EpiInProj {
    static constexpr bool PERM = true, AFTER_DRAIN = false;
    bf16_t *UP, *Q, *V, *GT; float* G; const float* lbl;
    __device__ __forceinline__ void operator()(const f32x4 (&acc)[2][2][4][2], const Unit& u, int wr, int wc, int fr, int fq) const {
        const int sec = u.pn >> 2, colt = (u.pn & 3) * BM;
        const int row0 = u.pm * BM + wr * 64 + fr, col0 = colt + wc * 32 + 8 * fq;
        if (sec == 2) {
#pragma unroll
            for (int bj = 0; bj < 2; ++bj) {
                float lb[8];
#pragma unroll
                for (int e = 0; e < 8; ++e) { const int c = col0 + bj * HALF + e; lb[e] = 1.0f / (1.0f + __expf(lbl[1024 + c] - lbl[c])); }
#pragma unroll
                for (int ai = 0; ai < 2; ++ai)
#pragma unroll
                    for (int m = 0; m < 4; ++m) {
                        float* rowp = G + (size_t)(row0 + ai * HALF + m * 16) * 1024 + col0 + bj * HALF;
                        f32x4 o0, o1;
#pragma unroll
                        for (int e = 0; e < 4; ++e) {
                            o0[e] = __logf(lb[e] + (1.0f - lb[e]) * sigmoidf_(acc[ai][bj][m][0][e]));
                            o1[e] = __logf(lb[4 + e] + (1.0f - lb[4 + e]) * sigmoidf_(acc[ai][bj][m][1][e]));
                        }
                        *(f32x4*)rowp = o0; *(f32x4*)(rowp + 4) = o1;
                    }
            }
        } else {
            bf16_t* base = sec == 0 ? UP : (sec == 1 ? Q : (sec == 3 ? V : GT));
#pragma unroll
            for (int ai = 0; ai < 2; ++ai)
#pragma unroll
                for (int m = 0; m < 4; ++m) {
                    bf16_t* rowp = base + (size_t)(row0 + ai * HALF + m * 16) * 1024 + col0;
#pragma unroll
                    for (int bj = 0; bj < 2; ++bj) {
                        f32x4 v0 = acc[ai][bj][m][0], v1 = acc[ai][bj][m][1];
                        if (sec == 4) {
#pragma unroll
                            for (int e = 0; e < 4; ++e) { v0[e] = v0[e] * sigmoidf_(v0[e]); v1[e] = v1[e] * sigmoidf_(v1[e]); }
                        }
                        u32x4 w; w.x = cvt_pk_bf16(v0[0], v0[1]); w.y = cvt_pk_bf16(v0[2], v0[3]); w.z = cvt_pk_bf16(v1[0], v1[1]); w.w = cvt_pk_bf16(v1[2], v1[3]);
                        *(u32x4*)(rowp + bj * HALF) = w;
                    }
                }
        }
    }
};
struct EpiBf16 {
    static constexpr bool PERM = true, AFTER_DRAIN = false;
    bf16_t* O; int ldc; const float* bias; const float* scale;
    __device__ __forceinline__ void operator()(const f32x4 (&acc)[2][2][4][2], const Unit& u, int wr, int wc, int fr, int fq) const {
        const int row0 = u.pm * BM + wr * 64 + fr, col0 = u.pn * BM + wc * 32 + 8 * fq;
        f32x4 bv[2][2], sv[2][2];
#pragma unroll
        for (int bj = 0; bj < 2; ++bj)
#pragma unroll
            for (int n = 0; n < 2; ++n) {
                bv[bj][n] = bias ? *(const f32x4*)(bias + col0 + bj * HALF + 4 * n) : (f32x4){0.f, 0.f, 0.f, 0.f};
                sv[bj][n] = scale ? *(const f32x4*)(scale + col0 + bj * HALF + 4 * n) : (f32x4){1.f, 1.f, 1.f, 1.f};
            }
#pragma unroll
        for (int ai = 0; ai < 2; ++ai)
#pragma unroll
            for (int m = 0; m < 4; ++m) {
                bf16_t* rowp = O + (size_t)(row0 + ai * HALF + m * 16) * ldc + col0;
#pragma unroll
                for (int bj = 0; bj < 2; ++bj) {
                    const f32x4 v0 = (acc[ai][bj][m][0] + bv[bj][0]) * sv[bj][0], v1 = (acc[ai][bj][m][1] + bv[bj][1]) * sv[bj][1];
                    u32x4 w; w.x = cvt_pk_bf16(v0[0], v0[1]); w.y = cvt_pk_bf16(v0[2], v0[3]); w.z = cvt_pk_bf16(v1[0], v1[1]); w.w = cvt_pk_bf16(v1[2], v1[3]);
                    *(u32x4*)(rowp + bj * HALF) = w;
                }
            }
    }
};
struct EpiResF32 {
    static constexpr bool PERM = true, AFTER_DRAIN = false;
    const float* base; float* out; int ldc; float alpha;
    __device__ __forceinline__ void operator()(const f32x4 (&acc)[2][2][4][2], const Unit& u, int wr, int wc, int fr, int fq) const {
        const int row0 = u.pm * BM + wr * 64 + fr, col0 = u.pn * BM + wc * 32 + 8 * fq;
#pragma unroll
        for (int ai = 0; ai < 2; ++ai)
#pragma unroll
            for (int m = 0; m < 4; ++m) {
                const size_t off = (size_t)(row0 + ai * HALF + m * 16) * ldc + col0;
#pragma unroll
                for (int bj = 0; bj < 2; ++bj) {
                    const f32x4 b0 = *(const f32x4*)(base + off + bj * HALF), b1 = *(const f32x4*)(base + off + bj * HALF + 4);
                    *(f32x4*)(out + off + bj * HALF) = b0 * alpha + acc[ai][bj][m][0];
                    *(f32x4*)(out + off + bj * HALF + 4) = b1 * alpha + acc[ai][bj][m][1];
                }
            }
    }
};
}
#define LAS __attribute__((address_space(3)))
typedef unsigned short bf16;
typedef float f32x4 __attribute__((ext_vector_type(4)));
typedef float f32x2 __attribute__((ext_vector_type(2)));
typedef unsigned u32x4 __attribute__((ext_vector_type(4)));
typedef unsigned u32x2 __attribute__((ext_vector_type(2)));
typedef short bf16x8 __attribute__((ext_vector_type(8)));
constexpr int NT = 512, NWAVES = 8;
constexpr int SEQ = 4096, M = 8192, DM = 2048, INC = 5120, PW = 1024, HW_ = 1024, FF = 5632, FF2 = 11264, NH = 8, CH = 64, NCH = SEQ / CH;
constexpr int NUNIT = 2 * NH * NCH;
constexpr float ALPHA = 1.189207115002721f, LN_EPS = 1e-5f, RMS_EPS = 1e-6f;
constexpr size_t MiB = 1u << 20;
constexpr size_t WS_WDN = 1 * MiB, WS_WPOOL = 23 * MiB, WS_WIN = 24 * MiB, WS_WOUT = 44 * MiB, WS_WUP = 52 * MiB, WS_X1B = 96 * MiB;
constexpr size_t WS_XB = 128 * MiB  , WS_UP = 160 * MiB, WS_Q = 176 * MiB, WS_G = 192 * MiB, WS_V = 224 * MiB, WS_GT = 240 * MiB, WS_PL = 256 * MiB, WS_S = 272 * MiB, WS_DEC = 336 * MiB;
constexpr size_t WS_U = 128 * MiB  , WS_HH = 24 * MiB  ;
constexpr size_t WS_END = 337 * MiB;
constexpr int LDS_BYTES = 147456;

__device__ __forceinline__ unsigned pk2(float lo, float hi) { return pg8::cvt_pk_bf16(lo, hi); }
__device__ __forceinline__ float bf2f(unsigned short h) { return __uint_as_float((unsigned)h << 16); }
__device__ __forceinline__ float bflo(unsigned w) { return __uint_as_float(w << 16); }
__device__ __forceinline__ float bfhi(unsigned w) { return __uint_as_float(w & 0xffff0000u); }
__device__ __forceinline__ float wave_sum(float v) {
#pragma unroll
    for (int o = 1; o < 64; o <<= 1) v += __shfl_xor(v, o);
    return v;
}
__device__ __forceinline__ float expc(float x) { return __expf(fminf(x, 80.0f)); }

__device__ __forceinline__ void p0_transpose_item(const float* W, int K, int N, bf16* WT, int row_off, LAS float* scr, int item, int lane) {
    const int nblk = N / 32, kb = item / nblk, nb = item % nblk, k0 = 64 * kb, n0 = 32 * nb;
#pragma unroll 8
    for (int i = 0; i < 32; ++i) { const int kk = 2 * i + (lane >> 5); scr[kk * 33 + (lane & 31)] = W[(size_t)(k0 + kk) * N + n0 + (lane & 31)]; }
    asm volatile("s_waitcnt lgkmcnt(0)" ::: "memory");
    const int c = lane & 7;
#pragma unroll
    for (int j = 0; j < 4; ++j) { const int n = (lane >> 3) + 8 * j; const LAS float* s = scr + (8 * c) * 33 + n;
        u32x4 o; o.x = pk2(s[0 * 33], s[1 * 33]); o.y = pk2(s[2 * 33], s[3 * 33]); o.z = pk2(s[4 * 33], s[5 * 33]); o.w = pk2(s[6 * 33], s[7 * 33]);
        *(u32x4*)(WT + (size_t)(row_off + n0 + n) * K + k0 + 8 * c) = o; }
    asm volatile("s_waitcnt lgkmcnt(0)" ::: "memory");
}

__device__ __forceinline__ void ln_rows(const float* Y, float* Xo, bf16* Xb, const float* gam, const float* bet, int gw, int ngw, int lane) {
    for (int r = gw; r < M; r += ngw) {
        const f32x4* yr = (const f32x4*)(Y + (size_t)r * DM) + lane;
        f32x4 v[8]; float s = 0.f;
#pragma unroll
        for (int j = 0; j < 8; ++j) { v[j] = yr[64 * j]; s += (v[j].x + v[j].y) + (v[j].z + v[j].w); }
        const float mean = wave_sum(s) * (1.f / DM); float s2 = 0.f;
#pragma unroll
        for (int j = 0; j < 8; ++j) { v[j] = v[j] - mean; s2 += (v[j].x * v[j].x + v[j].y * v[j].y) + (v[j].z * v[j].z + v[j].w * v[j].w); }
        const float rstd = 1.0f / sqrtf(wave_sum(s2) * (1.f / DM) + LN_EPS);
        f32x4* xo = (f32x4*)(Xo + (size_t)r * DM) + lane;
        u32x2* xb = Xb ? (u32x2*)(Xb + (size_t)r * DM) + lane : nullptr;
#pragma unroll
        for (int j = 0; j < 8; ++j) {
            const f32x4 g4 = ((const f32x4*)gam)[lane + 64 * j], b4 = ((const f32x4*)bet)[lane + 64 * j];
            const f32x4 o = v[j] * rstd * g4 + b4;
            xo[64 * j] = o;
            if (Xb) { u32x2 w; w.x = pk2(o.x, o.y); w.y = pk2(o.z, o.w); xb[64 * j] = w; }
        }
    }
}

__device__ __forceinline__ void hgrn_pass1(LAS unsigned char* lds, const float* G, const bf16* V, float* S, float* DEC, int unit) {
    const int tid = threadIdx.x, lane = tid & 63, wid = tid >> 6, fr = lane & 15, fq = lane >> 4;
    const int bh = unit >> 6, n = unit & 63, b = bh >> 3, h = bh & 7;
    const size_t row0 = (size_t)b * SEQ + (size_t)n * CH; const int c0 = h * 128;
    LAS float* parts = (LAS float*)lds;
    LAS bf16* KT = (LAS bf16*)(lds + 2048);
    LAS bf16* VT = (LAS bf16*)(lds + 2048 + 128 * 144);
    const int k = tid & 127, qd = tid >> 7;
    float g[16], bb[16]; unsigned short vv[16];
#pragma unroll
    for (int i = 0; i < 16; ++i) g[i] = G[(row0 + 16 * qd + i) * 1024 + c0 + k];
#pragma unroll
    for (int i = 0; i < 16; ++i) vv[i] = V[(row0 + 16 * qd + i) * 1024 + c0 + k];
    float run = 0.f;
#pragma unroll
    for (int i = 0; i < 16; ++i) { run += g[i]; bb[i] = run; }
    parts[qd * 128 + k] = run;
    __syncthreads();
    float off = 0.f, tot = 0.f;
#pragma unroll
    for (int j = 0; j < 4; ++j) { const float p = parts[j * 128 + k]; if (j < qd) off += p; tot += p; }
    float kt[16];
#pragma unroll
    for (int i = 0; i < 16; ++i) kt[i] = (1.0f - __expf(g[i])) * expc(tot - (bb[i] + off));
    u32x4 w0, w1;
    w0.x = pk2(kt[0], kt[1]); w0.y = pk2(kt[2], kt[3]); w0.z = pk2(kt[4], kt[5]); w0.w = pk2(kt[6], kt[7]);
    w1.x = pk2(kt[8], kt[9]); w1.y = pk2(kt[10], kt[11]); w1.z = pk2(kt[12], kt[13]); w1.w = pk2(kt[14], kt[15]);
    *(LAS u32x4*)(KT + k * 72 + 16 * qd) = w0; *(LAS u32x4*)(KT + k * 72 + 16 * qd + 8) = w1;
    u32x4 x0, x1;
    x0.x = vv[0] | ((unsigned)vv[1] << 16); x0.y = vv[2] | ((unsigned)vv[3] << 16); x0.z = vv[4] | ((unsigned)vv[5] << 16); x0.w = vv[6] | ((unsigned)vv[7] << 16);
    x1.x = vv[8] | ((unsigned)vv[9] << 16); x1.y = vv[10] | ((unsigned)vv[11] << 16); x1.z = vv[12] | ((unsigned)vv[13] << 16); x1.w = vv[14] | ((unsigned)vv[15] << 16);
    *(LAS u32x4*)(VT + k * 72 + 16 * qd) = x0; *(LAS u32x4*)(VT + k * 72 + 16 * qd + 8) = x1;
    if (qd == 0) DEC[(size_t)unit * 128 + k] = __expf(tot);
    __syncthreads();
    bf16x8 a[2];
#pragma unroll
    for (int kk = 0; kk < 2; ++kk) a[kk] = *(const LAS bf16x8*)(KT + (16 * wid + fr) * 72 + kk * 32 + 8 * fq);
    float* Su = S + (size_t)unit * 16384;
#pragma unroll
    for (int vb = 0; vb < 8; ++vb) {
        f32x4 acc = {0.f, 0.f, 0.f, 0.f};
#pragma unroll
        for (int kk = 0; kk < 2; ++kk) { const bf16x8 bfr = *(const LAS bf16x8*)(VT + (16 * vb + fr) * 72 + kk * 32 + 8 * fq); acc = __builtin_amdgcn_mfma_f32_16x16x32_bf16(a[kk], bfr, acc, 0, 0, 0); }
        *(f32x4*)(Su + (size_t)(16 * vb + fr) * 128 + 16 * wid + 4 * fq) = acc;
    }
    __syncthreads();
}

__device__ __forceinline__ void hgrn_pass3(LAS unsigned char* lds, const float* G, const bf16* Q, const bf16* V, const bf16* GT, const float* S, const float* gnorm, bf16* MIX, int unit) {
    const int tid = threadIdx.x, lane = tid & 63, wid = tid >> 6, fr = lane & 15, fq = lane >> 4;
    const int bh = unit >> 6, n = unit & 63, b = bh >> 3, h = bh & 7;
    const size_t row0 = (size_t)b * SEQ + (size_t)n * CH; const int c0 = h * 128;
    LAS float* parts = (LAS float*)lds;
    LAS float* EM = (LAS float*)(lds + 2048);
    LAS bf16* QM = (LAS bf16*)(lds + 3072);
    LAS bf16* KM = (LAS bf16*)(lds + 20480);
    LAS bf16* VT = (LAS bf16*)(lds + 37888);
    LAS bf16* P = (LAS bf16*)(lds + 56320);
    LAS bf16* ST = (LAS bf16*)(lds + 65536);
    LAS float* O = (LAS float*)(lds + 65536);
    const int k = tid & 127, qd = tid >> 7;
    float g[16], bb[16]; unsigned short qq[16], vv[16];
#pragma unroll
    for (int i = 0; i < 16; ++i) g[i] = G[(row0 + 16 * qd + i) * 1024 + c0 + k];
#pragma unroll
    for (int i = 0; i < 16; ++i) qq[i] = Q[(row0 + 16 * qd + i) * 1024 + c0 + k];
#pragma unroll
    for (int i = 0; i < 16; ++i) vv[i] = V[(row0 + 16 * qd + i) * 1024 + c0 + k];
    float run = 0.f;
#pragma unroll
    for (int i = 0; i < 16; ++i) { run += g[i]; bb[i] = run; }
    parts[qd * 128 + k] = run;
    __syncthreads();
    float off = 0.f;
#pragma unroll
    for (int j = 0; j < 4; ++j) { const float p = parts[j * 128 + k]; if (j < qd) off += p; }
    const float mref = parts[k] + parts[128 + k];
#pragma unroll
    for (int i = 0; i < 16; ++i) {
        const float bf = bb[i] + off; const int t = 16 * qd + i;
        const float qm = bf2f(qq[i]) * expc(bf - mref), km = (1.0f - __expf(g[i])) * expc(mref - bf);
        QM[t * 136 + k] = (bf16)(pk2(qm, 0.f) & 0xffffu); KM[t * 136 + k] = (bf16)(pk2(km, 0.f) & 0xffffu);
    }
    u32x4 x0, x1;
    x0.x = vv[0] | ((unsigned)vv[1] << 16); x0.y = vv[2] | ((unsigned)vv[3] << 16); x0.z = vv[4] | ((unsigned)vv[5] << 16); x0.w = vv[6] | ((unsigned)vv[7] << 16);
    x1.x = vv[8] | ((unsigned)vv[9] << 16); x1.y = vv[10] | ((unsigned)vv[11] << 16); x1.z = vv[12] | ((unsigned)vv[13] << 16); x1.w = vv[14] | ((unsigned)vv[15] << 16);
    *(LAS u32x4*)(VT + k * 72 + 16 * qd) = x0; *(LAS u32x4*)(VT + k * 72 + 16 * qd + 8) = x1;
    if (qd == 0) EM[k] = __expf(mref);
    __syncthreads();
    const float* Su = S + (size_t)unit * 16384;
#pragma unroll
    for (int j = 0; j < 8; ++j) {
        const int idx = tid + NT * j, v = idx >> 5, k4 = (idx & 31) * 4;
        const f32x4 s = *(const f32x4*)(Su + v * 128 + k4); const f32x4 em = *(const LAS f32x4*)(EM + k4);
        u32x2 w; w.x = pk2(s.x * em.x, s.y * em.y); w.y = pk2(s.z * em.z, s.w * em.w);
        *(LAS u32x2*)(ST + v * 136 + k4) = w;
    }
    {
        const int tb = wid >> 1;
        bf16x8 aq[4];
#pragma unroll
        for (int kk = 0; kk < 4; ++kk) aq[kk] = *(const LAS bf16x8*)(QM + (16 * tb + fr) * 136 + kk * 32 + 8 * fq);
#pragma unroll
        for (int j = 0; j < 2; ++j) {
            const int sb = 2 * (wid & 1) + j;
            f32x4 acc = {0.f, 0.f, 0.f, 0.f};
            if (sb <= tb) {
#pragma unroll
                for (int kk = 0; kk < 4; ++kk) { const bf16x8 bk = *(const LAS bf16x8*)(KM + (16 * sb + fr) * 136 + kk * 32 + 8 * fq); acc = __builtin_amdgcn_mfma_f32_16x16x32_bf16(aq[kk], bk, acc, 0, 0, 0); }
            }
            const int s = 16 * sb + fr;
#pragma unroll
            for (int r = 0; r < 4; ++r) { const int t = 16 * tb + 4 * fq + r; const float pv = (s <= t) ? acc[r] : 0.f; P[t * 72 + s] = (bf16)(pk2(pv, 0.f) & 0xffffu); }
        }
    }
    __syncthreads();
    f32x4 oacc[4];
    {
        bf16x8 bs[4], bv[2];
#pragma unroll
        for (int kk = 0; kk < 4; ++kk) bs[kk] = *(const LAS bf16x8*)(ST + (16 * wid + fr) * 136 + kk * 32 + 8 * fq);
#pragma unroll
        for (int kk = 0; kk < 2; ++kk) bv[kk] = *(const LAS bf16x8*)(VT + (16 * wid + fr) * 72 + kk * 32 + 8 * fq);
#pragma unroll
        for (int tb = 0; tb < 4; ++tb) {
            f32x4 acc = {0.f, 0.f, 0.f, 0.f};
#pragma unroll
            for (int kk = 0; kk < 4; ++kk) { const bf16x8 aq = *(const LAS bf16x8*)(QM + (16 * tb + fr) * 136 + kk * 32 + 8 * fq); acc = __builtin_amdgcn_mfma_f32_16x16x32_bf16(aq, bs[kk], acc, 0, 0, 0); }
#pragma unroll
            for (int kk = 0; kk < 2; ++kk) { const bf16x8 ap = *(const LAS bf16x8*)(P + (16 * tb + fr) * 72 + kk * 32 + 8 * fq); acc = __builtin_amdgcn_mfma_f32_16x16x32_bf16(ap, bv[kk], acc, 0, 0, 0); }
            oacc[tb] = acc;
        }
    }
    __syncthreads();
#pragma unroll
    for (int tb = 0; tb < 4; ++tb)
#pragma unroll
        for (int r = 0; r < 4; ++r) O[(16 * tb + 4 * fq + r) * 132 + 16 * wid + fr] = oacc[tb][r];
    __syncthreads();
    {
        const int t = tid >> 3, seg = tid & 7;
        f32x4 o[4]; float ss = 0.f;
#pragma unroll
        for (int j = 0; j < 4; ++j) { o[j] = *(const LAS f32x4*)(O + t * 132 + 16 * seg + 4 * j); ss += (o[j].x * o[j].x + o[j].y * o[j].y) + (o[j].z * o[j].z + o[j].w * o[j].w); }
        ss += __shfl_xor(ss, 1); ss += __shfl_xor(ss, 2); ss += __shfl_xor(ss, 4);
        const float r = 1.0f / sqrtf(ss * (1.0f / 128.0f) + RMS_EPS);
        const int c = c0 + 16 * seg;
        const u32x4 g0 = *(const u32x4*)(GT + (row0 + t) * 1024 + c), g1 = *(const u32x4*)(GT + (row0 + t) * 1024 + c + 8);
        const unsigned gw[8] = {g0.x, g0.y, g0.z, g0.w, g1.x, g1.y, g1.z, g1.w};
        unsigned ow[8];
#pragma unroll
        for (int j = 0; j < 4; ++j) {
            const f32x4 gn = *(const f32x4*)(gnorm + c + 4 * j);
            const float y0 = o[j].x * r * gn.x * bflo(gw[2 * j]), y1 = o[j].y * r * gn.y * bfhi(gw[2 * j]);
            const float y2 = o[j].z * r * gn.z * bflo(gw[2 * j + 1]), y3 = o[j].w * r * gn.w * bfhi(gw[2 * j + 1]);
            ow[2 * j] = pk2(y0, y1); ow[2 * j + 1] = pk2(y2, y3);
        }
        bf16* dst = MIX + (row0 + t) * DM + 1024 + c;
        *(u32x4*)dst = (u32x4){ow[0], ow[1], ow[2], ow[3]}; *(u32x4*)(dst + 8) = (u32x4){ow[4], ow[5], ow[6], ow[7]};
    }
    __syncthreads();
}

struct Args { const float* in[16]; float* out; unsigned char* ws; };
__global__ void __launch_bounds__(NT, 2) fwd_mega(Args a) {
    extern __shared__ __attribute__((aligned(16))) unsigned char lds_raw[];
    LAS unsigned char* lds = (LAS unsigned char*)lds_raw;
    cg::grid_group grid = cg::this_grid();
    const int tid = threadIdx.x, lane = tid & 63, wave = __builtin_amdgcn_readfirstlane(tid >> 6);
    const int G_ = gridDim.x, bx = blockIdx.x;
    const int gw = bx * NWAVES + wave, ngw = G_ * NWAVES;
    const int gt = bx * NT + tid, ngt = G_ * NT;
    const float *x = a.in[0], *w_in = a.in[1], *pool_w = a.in[2], *pool_b = a.in[3], *pool_scale = a.in[4], *lbl = a.in[5], *gnorm = a.in[6], *w_out = a.in[7],
                *ln1_g = a.in[8], *ln1_b = a.in[9], *w_up = a.in[10], *conv_w = a.in[11], *conv_b = a.in[12], *w_down = a.in[13], *ln2_g = a.in[14], *ln2_b = a.in[15];
    unsigned char* ws = a.ws; float* out = a.out;
    bf16 *Wdn = (bf16*)(ws + WS_WDN), *Wpool = (bf16*)(ws + WS_WPOOL), *Win = (bf16*)(ws + WS_WIN), *Wout = (bf16*)(ws + WS_WOUT), *Wup = (bf16*)(ws + WS_WUP), *X1B = (bf16*)(ws + WS_X1B);
    bf16 *XB = (bf16*)(ws + WS_XB), *MIX = (bf16*)(ws + WS_XB), *UP = (bf16*)(ws + WS_UP), *Qb = (bf16*)(ws + WS_Q), *Vb = (bf16*)(ws + WS_V), *GT = (bf16*)(ws + WS_GT), *PL = (bf16*)(ws + WS_PL);
    float *Gf = (float*)(ws + WS_G), *Sst = (float*)(ws + WS_S), *DEC = (float*)(ws + WS_DEC);
    bf16 *U = (bf16*)(ws + WS_U), *HH = (bf16*)(ws + WS_HH);

    {
        LAS float* scr = (LAS float*)(lds + wave * 16384);
        constexpr int I_IN = (DM / 64) * (INC / 32), I_OUT = (DM / 64) * (DM / 32), I_UP = (DM / 64) * (FF2 / 32), I_DN = (FF / 64) * (DM / 32), I_PL = (256 / 64) * (256 / 32);
        constexpr int NITEMS = I_IN + I_OUT + I_UP + I_DN + 4 * I_PL;
        for (int it = gw; it < NITEMS; it += ngw) {
            int r = it;
            if (r < I_IN) { p0_transpose_item(w_in, DM, INC, Win, 0, scr, r, lane); continue; } r -= I_IN;
            if (r < I_OUT) { p0_transpose_item(w_out, DM, DM, Wout, 0, scr, r, lane); continue; } r -= I_OUT;
            if (r < I_UP) { p0_transpose_item(w_up, DM, FF2, Wup, 0, scr, r, lane); continue; } r -= I_UP;
            if (r < I_DN) { p0_transpose_item(w_down, FF, DM, Wdn, 0, scr, r, lane); continue; } r -= I_DN;
            { const int gi = r / I_PL; p0_transpose_item(pool_w + (size_t)gi * 65536, 256, 256, Wpool, gi * 256, scr, r % I_PL, lane); }
        }
        for (int i = gt; i < M * DM / 8; i += ngt) {
            const f32x4 v0 = ((const f32x4*)x)[2 * i], v1 = ((const f32x4*)x)[2 * i + 1];
            ((u32x4*)XB)[i] = (u32x4){pk2(v0.x, v0.y), pk2(v0.z, v0.w), pk2(v1.x, v1.y), pk2(v1.z, v1.w)};
        }
    }
    grid.sync();
    {
        pg8::Gemm g{XB, Win, M, INC, DM, DM, 0}; pg8::StaticOrder S; S.init(M, INC, G_, bx);
        pg8::EpiInProj E{UP, Qb, Vb, GT, Gf, lbl};
        pg8::gemm_phase<pg8::EpiInProj, pg8::StaticOrder, true, true>(lds, g, S, E);
    }
    grid.sync();
    {
        for (int it = gt; it < M * 128; it += ngt) {
            const int row = it >> 7, c8 = (it & 127) * 8, gi = c8 >> 8, w = 2 << gi, t = row & (SEQ - 1), nw = (t + 1 < w) ? t + 1 : w;
            float s[8] = {0.f, 0.f, 0.f, 0.f, 0.f, 0.f, 0.f, 0.f}; float u0[8];
            for (int j = 0; j < nw; ++j) {
                const u32x4 q = *(const u32x4*)(UP + (size_t)(row - j) * 1024 + c8);
                const float f[8] = {bflo(q.x), bfhi(q.x), bflo(q.y), bfhi(q.y), bflo(q.z), bfhi(q.z), bflo(q.w), bfhi(q.w)};
#pragma unroll
                for (int e = 0; e < 8; ++e) { s[e] += f[e]; if (j == 0) u0[e] = f[e]; }
            }
            const float inv = 1.0f / (float)nw;
            *(u32x4*)(PL + (size_t)row * 1024 + c8) = (u32x4){pk2(s[0] * inv - u0[0], s[1] * inv - u0[1]), pk2(s[2] * inv - u0[2], s[3] * inv - u0[3]),
                                                              pk2(s[4] * inv - u0[4], s[5] * inv - u0[5]), pk2(s[6] * inv - u0[6], s[7] * inv - u0[7])};
        }
        for (int u = bx; u < NUNIT; u += G_) hgrn_pass1(lds, Gf, Vb, Sst, DEC, u);
    }
    grid.sync();
    {
        for (int it = gt; it < 16 * 8192; it += ngt) {
            const int bh = it >> 13, e2 = it & 8191, k = (2 * e2) & 127;
            f32x2* p = (f32x2*)(Sst + (size_t)bh * 64 * 16384) + e2; const float* d = DEC + (size_t)bh * 64 * 128 + k;
            f32x2 run = {0.f, 0.f};
#pragma unroll 8
            for (int n = 0; n < NCH; ++n) { const f32x2 t = p[(size_t)n * 8192]; const f32x2 dd = *(const f32x2*)(d + n * 128); p[(size_t)n * 8192] = run; run = dd * run + t; }
        }
        pg8::Gemm g{PL, Wpool, M, PW, 256, PW, 256}; pg8::StaticOrder S; S.init(M, PW, G_, bx);
        pg8::EpiBf16 E{MIX, DM, pool_b, pool_scale};
        pg8::gemm_phase<pg8::EpiBf16, pg8::StaticOrder, true, true>(lds, g, S, E);
    }
    grid.sync();
    for (int u = bx; u < NUNIT; u += G_) hgrn_pass3(lds, Gf, Qb, Vb, GT, Sst, gnorm, MIX, u);
    grid.sync();
    {
        pg8::Gemm g{MIX, Wout, M, DM, DM, DM, 0}; pg8::StaticOrder S; S.init(M, DM, G_, bx);
        pg8::EpiResF32 E{x, out, DM, ALPHA};
        pg8::gemm_phase<pg8::EpiResF32, pg8::StaticOrder, true, true>(lds, g, S, E);
    }
    grid.sync();
    ln_rows(out, out, X1B, ln1_g, ln1_b, gw, ngw, lane);
    grid.sync();
    {
        pg8::Gemm g{X1B, Wup, M, FF2, DM, DM, 0}; pg8::StaticOrder S; S.init(M, FF2, G_, bx);
        pg8::EpiBf16 E{U, FF2, nullptr, nullptr};
        pg8::gemm_phase<pg8::EpiBf16, pg8::StaticOrder, true, true>(lds, g, S, E);
    }
    grid.sync();
    {
        constexpr int NCW = FF / 512, NSEG = M / 8;
        for (int wi = gw; wi < NCW * NSEG; wi += ngw) {
            const int cw = wi % NCW, seg = wi / NCW, c = (cw * 64 + lane) * 8, r0 = seg * 8, t0 = r0 & (SEQ - 1);
            float wg[3][8], wv[3][8], cbg[8], cbv[8];
#pragma unroll
            for (int j = 0; j < 3; ++j)
#pragma unroll
                for (int e = 0; e < 8; ++e) { wg[j][e] = conv_w[(size_t)j * FF2 + c + e]; wv[j][e] = conv_w[(size_t)j * FF2 + FF + c + e]; }
#pragma unroll
            for (int e = 0; e < 8; ++e) { cbg[e] = conv_b[c + e]; cbv[e] = conv_b[FF + c + e]; }
            float pg[2][8], pv[2][8];
#pragma unroll
            for (int j = 0; j < 2; ++j) {
                if (t0 - 2 + j >= 0) {
                    const u32x4 qg = *(const u32x4*)(U + (size_t)(r0 - 2 + j) * FF2 + c), qv = *(const u32x4*)(U + (size_t)(r0 - 2 + j) * FF2 + FF + c);
                    const float fg[8] = {bflo(qg.x), bfhi(qg.x), bflo(qg.y), bfhi(qg.y), bflo(qg.z), bfhi(qg.z), bflo(qg.w), bfhi(qg.w)};
                    const float fv[8] = {bflo(qv.x), bfhi(qv.x), bflo(qv.y), bfhi(qv.y), bflo(qv.z), bfhi(qv.z), bflo(qv.w), bfhi(qv.w)};
#pragma unroll
                    for (int e = 0; e < 8; ++e) { pg[j][e] = fg[e]; pv[j][e] = fv[e]; }
                } else {
#pragma unroll
                    for (int e = 0; e < 8; ++e) { pg[j][e] = 0.f; pv[j][e] = 0.f; }
                }
            }
#pragma unroll
            for (int i = 0; i < 8; ++i) {
                const u32x4 qg = *(const u32x4*)(U + (size_t)(r0 + i) * FF2 + c), qv = *(const u32x4*)(U + (size_t)(r0 + i) * FF2 + FF + c);
                const float fg[8] = {bflo(qg.x), bfhi(qg.x), bflo(qg.y), bfhi(qg.y), bflo(qg.z), bfhi(qg.z), bflo(qg.w), bfhi(qg.w)};
                const float fv[8] = {bflo(qv.x), bfhi(qv.x), bflo(qv.y), bfhi(qv.y), bflo(qv.z), bfhi(qv.z), bflo(qv.w), bfhi(qv.w)};
                float hv[8];
#pragma unroll
                for (int e = 0; e < 8; ++e) {
                    const float gc = cbg[e] + wg[0][e] * pg[0][e] + wg[1][e] * pg[1][e] + wg[2][e] * fg[e];
                    const float vc = cbv[e] + wv[0][e] * pv[0][e] + wv[1][e] * pv[1][e] + wv[2][e] * fv[e];
                    hv[e] = gc / (1.0f + __expf(-gc)) * vc;
                    pg[0][e] = pg[1][e]; pg[1][e] = fg[e]; pv[0][e] = pv[1][e]; pv[1][e] = fv[e];
                }
                *(u32x4*)(HH + (size_t)(r0 + i) * FF + c) = (u32x4){pk2(hv[0], hv[1]), pk2(hv[2], hv[3]), pk2(hv[4], hv[5]), pk2(hv[6], hv[7])};
            }
        }
    }
    grid.sync();
    {
        pg8::Gemm g{HH, Wdn, M, DM, FF, FF, 0}; pg8::StaticOrder S; S.init(M, DM, G_, bx);
        pg8::EpiResF32 E{out, out, DM, ALPHA};
        pg8::gemm_phase<pg8::EpiResF32, pg8::StaticOrder, true, true>(lds, g, S, E);
    }
    grid.sync();
    ln_rows(out, out, nullptr, ln2_g, ln2_b, gw, ngw, lane);
}

extern "C" void kernel_launch(void* const* d_in, const int* in_sizes, int n_in, void* d_out, int out_size, void* d_ws, size_t ws_size, hipStream_t stream) {
    static int grid = 0;
    if (grid == 0) {
        if (n_in != 16 || in_sizes[0] != M * DM || out_size != M * DM || ws_size < WS_END) { fprintf(stderr, "kernel_launch: unexpected shapes/ws (n_in %d, ws %zu)\n", n_in, ws_size); grid = -1; return; }
        int dev = 0, cus = 0, per_cu = 0;
        hipGetDevice(&dev); hipDeviceGetAttribute(&cus, hipDeviceAttributeMultiprocessorCount, dev);
        hipFuncSetAttribute((const void*)fwd_mega, hipFuncAttributeMaxDynamicSharedMemorySize, LDS_BYTES);
        hipOccupancyMaxActiveBlocksPerMultiprocessor(&per_cu, (const void*)fwd_mega, NT, LDS_BYTES);
        if (per_cu < 1) { fprintf(stderr, "kernel_launch: occupancy query says %d blocks/CU\n", per_cu); per_cu = 1; }
        if (per_cu > 1) per_cu = 1;
        grid = cus * per_cu;
    }
    if (grid < 0) return;
    Args a{};
    for (int i = 0; i < 16; ++i) a.in[i] = (const float*)d_in[i];
    a.out = (float*)d_out; a.ws = (unsigned char*)d_ws;
    void* args[] = {&a};
    hipError_t e = hipLaunchCooperativeKernel((const void*)fwd_mega, dim3(grid), dim3(NT), args, LDS_BYTES, stream);
    if (e != hipSuccess) fprintf(stderr, "cooperative launch failed: %s (grid %d)\n", hipGetErrorString(e), grid);
}
```

```cpp
#include <hip/hip_runtime.h>
#include <hip/hip_cooperative_groups.h>
#include <cstdio>
#include <cstdint>
namespace cg = cooperative_groups;
namespace pg8 {
#define PG8_LAS __attribute__((address_space(3)))
typedef unsigned short bf16_t;
typedef short bf16x8 __attribute__((ext_vector_type(8)));
typedef float f32x4 __attribute__((ext_vector_type(4)));
typedef unsigned u32x4 __attribute__((ext_vector_type(4)));
constexpr int BM = 256, BK = 64, HALF = 128, HTB = HALF * BK * 2  , STAGE_BYTES = 8 * HTB, NXCD = 8, WGM = 8;

__host__ __device__ __forceinline__ int lds_byte(int r, int c) { const int st = (r >> 4) * 2 + (c >> 5), rr = r & 15, cc = c & 31, ob = rr * 64 + cc * 2; return st * 1024 + (ob ^ (((ob >> 9) & 1) << 5)); }
__host__ __device__ __forceinline__ void stage_rc(int b, int& R, int& C) { const int st = b / 1024, sb = b % 1024, swz = sb ^ (((sb >> 9) & 1) << 5); R = (st >> 1) * 16 + swz / 64; C = (st & 1) * 32 + (swz % 64) / 2; }
__host__ __device__ __forceinline__ int perm32(int rho) { const int n = rho >> 4, i = rho & 15; return 8 * (i >> 2) + 4 * n + (i & 3); }

struct Unit { int pm, pn; };
struct Gemm { const bf16_t* A; const bf16_t* Bt; int M, N, K, lda, apn; };

struct StaticOrder {
    int nM, nN, nwg, G, c;
    __host__ __device__ void init(int M, int N, int G_, int c_) { nM = M / BM; nN = N / BM; nwg = nM * nN; G = G_; c = c_; }
    __host__ __device__ bool next(int i, Unit& u) const {
        const long L = (long)i * G + c; if (L >= nwg) return false;
        int wgid = (int)L; { const int q = nwg / NXCD, r = nwg % NXCD, xcd = wgid % NXCD, off = wgid / NXCD; wgid = (xcd < r ? xcd * (q + 1) : r * (q + 1) + (xcd - r) * q) + off; }
        const int nig = WGM * nN, gid = wgid / nig, fm = gid * WGM, gsz = (nM - fm) < WGM ? (nM - fm) : WGM;
        u.pm = fm + ((wgid % nig) % gsz); u.pn = (wgid % nig) / gsz; return true;
    }
    __device__ __forceinline__ void a_ready(const Unit&) const {}
    __device__ __forceinline__ void done(const Unit&) const {}
};

__device__ __forceinline__ unsigned cvt_pk_bf16(float lo, float hi) { unsigned r; asm volatile("v_cvt_pk_bf16_f32 %0, %1, %2" : "=v"(r) : "v"(lo), "v"(hi)); return r; }
typedef float f32x2 __attribute__((ext_vector_type(2)));
template <class Epi, class Sched, bool ALIGN_EPI = false, bool SP2 = false>
__device__ __forceinline__ void gemm_phase(PG8_LAS unsigned char* lds, const Gemm g, const Sched& S, const Epi& E) {
    const int tid = threadIdx.x, wid = __builtin_amdgcn_readfirstlane(tid >> 6), lane = tid & 63, wr = wid >> 2, wc = wid & 3, fr = lane & 15, fq = lane >> 4;
    const int K = g.K, nt = K / BK;
    unsigned voffA[2], voffB[2];
#pragma unroll
    for (int i = 0; i < 2; ++i) { int R, C; stage_rc(tid * 16 + i * 8192, R, C); const int Rb = Epi::PERM ? ((R & ~31) + perm32(R & 31)) : R;
        voffA[i] = (unsigned)(R * g.lda + C) * 2u; voffB[i] = (unsigned)(Rb * K + C) * 2u; }
    const size_t kstep = (size_t)(BK * 2);
    const size_t hstepA = (size_t)HALF * g.lda * 2, hstepB = (size_t)HALF * K * 2;
    const size_t tstepA = 2 * hstepA, tstepB = 2 * hstepB, apnb = (size_t)g.apn * 2;
    const unsigned ldsw = (unsigned)wid * 1024u;
    const int aoff = lds_byte(wr * 64 + fr, fq * 8), boff = lds_byte(wc * 32 + fr, fq * 8);
#define PG8_SA(b, h) (((b) * 2 + (h)) * HTB)
#define PG8_SB(b, h) ((4 + (b) * 2 + (h)) * HTB)
#define PG8_STAGE(bufoff, gbase, voff) do { _Pragma("unroll") for (int _i = 0; _i < 2; ++_i) \
        __builtin_amdgcn_global_load_lds((const unsigned*)((const char*)(gbase) + (voff)[_i]), (PG8_LAS unsigned*)(lds + (bufoff) + ldsw + _i * 8192), 16, 0, 0); } while (0)
#define PG8_LDA(dst, b, h) do { _Pragma("unroll") for (int m = 0; m < 4; ++m) _Pragma("unroll") for (int k = 0; k < 2; ++k) dst[m][k] = *(const PG8_LAS bf16x8*)(lds + PG8_SA(b, h) + aoff + m * 2048 + k * 1024); } while (0)
#define PG8_LDB(dst, b, h) do { _Pragma("unroll") for (int n = 0; n < 2; ++n) _Pragma("unroll") for (int k = 0; k < 2; ++k) dst[n][k] = *(const PG8_LAS bf16x8*)(lds + PG8_SB(b, h) + boff + n * 2048 + k * 1024); } while (0)
#define PG8_MMA(ai, bj, At, Bt) do { __builtin_amdgcn_s_setprio(1); _Pragma("unroll") for (int m = 0; m < 4; ++m) _Pragma("unroll") for (int n = 0; n < 2; ++n) _Pragma("unroll") for (int k = 0; k < 2; ++k) \
        acc[ai][bj][m][n] = __builtin_amdgcn_mfma_f32_16x16x32_bf16(Bt[n][k], At[m][k], acc[ai][bj][m][n], 0, 0, 0); __builtin_amdgcn_s_setprio(0); } while (0)
#define PG8_WAIT_V(n) asm volatile("s_waitcnt vmcnt(" #n ")" ::: "memory")
#define PG8_WAIT_L(n) asm volatile("s_waitcnt lgkmcnt(" #n ")" ::: "memory")
#define PG8_BAR __builtin_amdgcn_s_barrier()
#define PG8_SCHED __builtin_amdgcn_sched_barrier(0)
    Unit cur, nxt; int ui = 0;
    if (!S.next(0, cur)) return;
    f32x4 acc[2][2][4][2];
#pragma unroll
    for (int a = 0; a < 2; ++a)
#pragma unroll
        for (int b = 0; b < 2; ++b)
#pragma unroll
            for (int m = 0; m < 4; ++m)
#pragma unroll
                for (int n = 0; n < 2; ++n) acc[a][b][m][n] = (f32x4){0.f, 0.f, 0.f, 0.f};
    bf16x8 At[4][2], B0[2][2], B1[2][2];
    const char* cA = (const char*)g.A + (size_t)cur.pm * tstepA + (size_t)cur.pn * apnb; const char* cB = (const char*)g.Bt + (size_t)cur.pn * tstepB;
    S.a_ready(cur);
    if constexpr (SP2) {
        PG8_STAGE(PG8_SB(0, 0), cB, voffB); PG8_STAGE(PG8_SB(0, 1), cB + hstepB, voffB); PG8_STAGE(PG8_SA(0, 0), cA, voffA); PG8_STAGE(PG8_SA(0, 1), cA + hstepA, voffA);
        if (wr == 1) PG8_BAR;
        PG8_WAIT_V(2); PG8_BAR;
        PG8_STAGE(PG8_SB(1, 0), cB + kstep, voffB); PG8_STAGE(PG8_SA(1, 0), cA + kstep, voffA); PG8_STAGE(PG8_SB(1, 1), cB + hstepB + kstep, voffB);
        PG8_WAIT_V(6); PG8_BAR;
    } else {
        PG8_STAGE(PG8_SB(0, 0), cB, voffB); PG8_STAGE(PG8_SA(0, 0), cA, voffA); PG8_STAGE(PG8_SB(0, 1), cB + hstepB, voffB); PG8_STAGE(PG8_SA(0, 1), cA + hstepA, voffA);
        if (wr == 1) PG8_BAR;
        PG8_WAIT_V(4); PG8_BAR;
        PG8_STAGE(PG8_SB(1, 0), cB + kstep, voffB); PG8_STAGE(PG8_SA(1, 0), cA + kstep, voffA); PG8_STAGE(PG8_SB(1, 1), cB + hstepB + kstep, voffB);
        PG8_WAIT_V(6); PG8_BAR;
    }
    for (;;) {
        const bool has_next = S.next(ui + 1, nxt);
        const char* nA = has_next ? (const char*)g.A + (size_t)nxt.pm * tstepA + (size_t)nxt.pn * apnb : cA; const char* nB = has_next ? (const char*)g.Bt + (size_t)nxt.pn * tstepB : cB;
        for (int t = 0; t < nt; t += 2) {
            const bool last = (t == nt - 2);
            const char* a1 = cA + (size_t)(t + 1) * kstep;
            const char* a2 = last ? nA : cA + (size_t)(t + 2) * kstep; const char* b2 = last ? nB : cB + (size_t)(t + 2) * kstep;
            const char* a3 = a2 + kstep; const char* b3 = b2 + kstep;
            if (last && has_next) S.a_ready(nxt);
            if constexpr (SP2) {
            PG8_LDB(B0, 0, 0); PG8_LDB(B1, 0, 1); PG8_SCHED; PG8_LDA(At, 0, 0); PG8_STAGE(PG8_SA(1, 1), a1 + hstepA, voffA);
            PG8_WAIT_V(8); PG8_WAIT_L(0); PG8_BAR; PG8_MMA(0, 0, At, B0); PG8_MMA(0, 1, At, B1); PG8_BAR; PG8_SCHED;
            PG8_LDA(At, 0, 1); PG8_STAGE(PG8_SB(0, 0), b2, voffB); PG8_STAGE(PG8_SB(0, 1), b2 + hstepB, voffB); PG8_STAGE(PG8_SA(0, 0), a2, voffA);
            PG8_WAIT_V(8); PG8_WAIT_L(0); PG8_BAR; PG8_MMA(1, 0, At, B0); PG8_MMA(1, 1, At, B1); PG8_BAR; PG8_SCHED;
            PG8_LDB(B0, 1, 0); PG8_LDB(B1, 1, 1); PG8_SCHED; PG8_LDA(At, 1, 0); PG8_STAGE(PG8_SA(0, 1), a2 + hstepA, voffA);
            PG8_WAIT_V(8); PG8_WAIT_L(0); PG8_BAR; PG8_MMA(0, 0, At, B0); PG8_MMA(0, 1, At, B1); PG8_BAR; PG8_SCHED;
            PG8_LDA(At, 1, 1); PG8_STAGE(PG8_SB(1, 0), b3, voffB); PG8_STAGE(PG8_SB(1, 1), b3 + hstepB, voffB); PG8_STAGE(PG8_SA(1, 0), a3, voffA);
            PG8_WAIT_V(8); PG8_WAIT_L(0); PG8_BAR; PG8_MMA(1, 0, At, B0); PG8_MMA(1, 1, At, B1); PG8_BAR; PG8_SCHED;
            } else {
            PG8_LDB(B0, 0, 0); PG8_SCHED; PG8_LDA(At, 0, 0); PG8_STAGE(PG8_SA(1, 1), a1 + hstepA, voffA);
            PG8_WAIT_L(8); PG8_BAR; PG8_WAIT_L(0); PG8_MMA(0, 0, At, B0); PG8_BAR; PG8_SCHED;
            PG8_LDB(B1, 0, 1); PG8_STAGE(PG8_SB(0, 0), b2, voffB);
            PG8_BAR; PG8_WAIT_L(0); PG8_MMA(0, 1, At, B1); PG8_BAR;
            PG8_LDA(At, 0, 1); PG8_STAGE(PG8_SA(0, 0), a2, voffA);
            PG8_BAR; PG8_WAIT_L(0); PG8_MMA(1, 0, At, B0); PG8_BAR; PG8_SCHED;
            PG8_STAGE(PG8_SB(0, 1), b2 + hstepB, voffB);
            PG8_WAIT_V(6); PG8_BAR; PG8_MMA(1, 1, At, B1); PG8_BAR;
            PG8_LDB(B0, 1, 0); PG8_SCHED; PG8_LDA(At, 1, 0); PG8_STAGE(PG8_SA(0, 1), a2 + hstepA, voffA);
            PG8_WAIT_L(8); PG8_BAR; PG8_WAIT_L(0); PG8_MMA(0, 0, At, B0); PG8_BAR; PG8_SCHED;
            PG8_LDB(B1, 1, 1); PG8_STAGE(PG8_SB(1, 0), b3, voffB);
            PG8_BAR; PG8_WAIT_L(0); PG8_MMA(0, 1, At, B1); PG8_BAR;
            PG8_LDA(At, 1, 1); PG8_STAGE(PG8_SA(1, 0), a3, voffA);
            PG8_BAR; PG8_WAIT_L(0); PG8_MMA(1, 0, At, B0); PG8_BAR; PG8_SCHED;
            PG8_STAGE(PG8_SB(1, 1), b3 + hstepB, voffB);
            PG8_WAIT_V(6); PG8_BAR; PG8_MMA(1, 1, At, B1); PG8_BAR;
            }
        }
        if constexpr (ALIGN_EPI) { if (wr == 0) PG8_BAR; }
        if constexpr (!Epi::AFTER_DRAIN) { E(acc, cur, wr, wc, fr, fq); S.done(cur); }
        if (!has_next) break;
#pragma unroll
        for (int a = 0; a < 2; ++a)
#pragma unroll
            for (int b = 0; b < 2; ++b)
#pragma unroll
                for (int m = 0; m < 4; ++m)
#pragma unroll
                    for (int n = 0; n < 2; ++n) acc[a][b][m][n] = (f32x4){0.f, 0.f, 0.f, 0.f};
        cur = nxt; cA = nA; cB = nB; ++ui;
        if constexpr (ALIGN_EPI) { if (wr == 1) PG8_BAR; }
    }
    PG8_WAIT_V(0);
    if constexpr (!ALIGN_EPI) { if (wr == 0) PG8_BAR; }
    PG8_BAR;
    if constexpr (Epi::AFTER_DRAIN) { E.fused(acc, cur, wr, wc, fr, fq, lds, wid, lane); S.done(cur); }
#undef PG8_SA
#undef PG8_SB
#undef PG8_STAGE
#undef PG8_LDA
#undef PG8_LDB
#undef PG8_MMA
#undef PG8_WAIT_V
#undef PG8_WAIT_L
#undef PG8_BAR
#undef PG8_SCHED
}
}
namespace pg8 {
__device__ __forceinline__ float sigmoidf_(float x) { return 1.0f / (1.0f + __expf(-x)); }
struct EpiInProj {
    static constexpr bool PERM = true, AFTER_DRAIN = false;
    bf16_t *UP, *Q, *V, *GT; float* G; const float* lbl;
    __device__ __forceinline__ void operator()(const f32x4 (&acc)[2][2][4][2], const Unit& u, int wr, int wc, int fr, int fq) const {
        const int sec = u.pn >> 2, colt = (u.pn & 3) * BM;
        const int row0 = u.pm * BM + wr * 64 + fr, col0 = colt + wc * 32 + 8 * fq;
        if (sec == 2) {
#pragma unroll
            for (int bj = 0; bj < 2; ++bj) {
                float lb[8];
#pragma unroll
                for (int e = 0; e < 8; ++e) { const int c = col0 + bj * HALF + e; lb[e] = 1.0f / (1.0f + __expf(lbl[1024 + c] - lbl[c])); }
#pragma unroll
                for (int ai = 0; ai < 2; ++ai)
#pragma unroll
                    for (int m = 0; m < 4; ++m) {
                        float* rowp = G + (size_t)(row0 + ai * HALF + m * 16) * 1024 + col0 + bj * HALF;
                        f32x4 o0, o1;
#pragma unroll
                        for (int e = 0; e < 4; ++e) {
                            o0[e] = __logf(lb[e] + (1.0f - lb[e]) * sigmoidf_(acc[ai][bj][m][0][e]));
                            o1[e] = __logf(lb[4 + e] + (1.0f - lb[4 + e]) * sigmoidf_(acc[ai][bj][m][1][e]));
                        }
                        *(f32x4*)rowp = o0; *(f32x4*)(rowp + 4) = o1;
                    }
            }
        } else {
            bf16_t* base = sec == 0 ? UP : (sec == 1 ? Q : (sec == 3 ? V : GT));
#pragma unroll
            for (int ai = 0; ai < 2; ++ai)
#pragma unroll
                for (int m = 0; m < 4; ++m) {
                    bf16_t* rowp = base + (size_t)(row0 + ai * HALF + m * 16) * 1024 + col0;
#pragma unroll
                    for (int bj = 0; bj < 2; ++bj) {
                        f32x4 v0 = acc[ai][bj][m][0], v1 = acc[ai][bj][m][1];
                        if (sec == 4) {
#pragma unroll
                            for (int e = 0; e < 4; ++e) { v0[e] = v0[e] * sigmoidf_(v0[e]); v1[e] = v1[e] * sigmoidf_(v1[e]); }
                        }
                        u32x4 w; w.x = cvt_pk_bf16(v0[0], v0[1]); w.y = cvt_pk_bf16(v0[2], v0[3]); w.z = cvt_pk_bf16(v1[0], v1[1]); w.w = cvt_pk_bf16(v1[2], v1[3]);
                        *(u32x4*)(rowp + bj * HALF) = w;
                    }
                }
        }
    }
};
struct EpiBf16 {
    static constexpr bool PERM = true, AFTER_DRAIN = false;
    bf16_t* O; int ldc; const float* bias; const float* scale;
    __device__ __forceinline__ void operator()(const f32x4 (&acc)[2][2][4][2], const Unit& u, int wr, int wc, int fr, int fq) const {
        const int row0 = u.pm * BM + wr * 64 + fr, col0 = u.pn * BM + wc * 32 + 8 * fq;
        f32x4 bv[2][2], sv[2][2];
#pragma unroll
        for (int bj = 0; bj < 2; ++bj)
#pragma unroll
            for (int n = 0; n < 2; ++n) {
                bv[bj][n] = bias ? *(const f32x4*)(bias + col0 + bj * HALF + 4 * n) : (f32x4){0.f, 0.f, 0.f, 0.f};
                sv[bj][n] = scale ? *(const f32x4*)(scale + col0 + bj * HALF + 4 * n) : (f32x4){1.f, 1.f, 1.f, 1.f};
            }
#pragma unroll
        for (int ai = 0; ai < 2; ++ai)
#pragma unroll
            for (int m = 0; m < 4; ++m) {
                bf16_t* rowp = O + (size_t)(row0 + ai * HALF + m * 16) * ldc + col0;
#pragma unroll
                for (int bj = 0; bj < 2; ++bj) {
                    const f32x4 v0 = (acc[ai][bj][m][0] + bv[bj][0]) * sv[bj][0], v1 = (acc[ai][bj][m][1] + bv[bj][1]) * sv[bj][1];
                    u32x4 w; w.x = cvt_pk_bf16(v0[0], v0[1]); w.y = cvt_pk_bf16(v0[2], v0[3]); w.z = cvt_pk_bf16(v1[0], v1[1]); w.w = cvt_pk_bf16(v1[2], v1[3]);
                    *(u32x4*)(rowp + bj * HALF) = w;
                }
            }
    }
};
struct EpiResF32 {
    static constexpr bool PERM = true, AFTER_DRAIN = false;
    const float* base; float* out; int ldc; float alpha;
    __device__ __forceinline__ void operator()(const f32x4 (&acc)[2][2][4][2], const Unit& u, int wr, int wc, int fr, int fq) const {
        const int row0 = u.pm * BM + wr * 64 + fr, col0 = u.pn * BM + wc * 32 + 8 * fq;
#pragma unroll
        for (int ai = 0; ai < 2; ++ai)
#pragma unroll
            for (int m = 0; m < 4; ++m) {
                const size_t off = (size_t)(row0 + ai * HALF + m * 16) * ldc + col0;
#pragma unroll
                for (int bj = 0; bj < 2; ++bj) {
                    const f32x4 b0 = *(const f32x4*)(base + off + bj * HALF), b1 = *(const f32x4*)(base + off + bj * HALF + 4);
                    *(f32x4*)(out + off + bj * HALF) = b0 * alpha + acc[ai][bj][m][0];
                    *(f32x4*)(out + off + bj * HALF + 4) = b1 * alpha + acc[ai][bj][m][1];
                }
            }
    }
};
}
#define LAS __attribute__((address_space(3)))
typedef unsigned short bf16;
typedef float f32x4 __attribute__((ext_vector_type(4)));
typedef float f32x2 __attribute__((ext_vector_type(2)));
typedef unsigned u32x4 __attribute__((ext_vector_type(4)));
typedef unsigned u32x2 __attribute__((ext_vector_type(2)));
typedef short bf16x8 __attribute__((ext_vector_type(8)));
constexpr int NT = 512, NWAVES = 8;
constexpr int SEQ = 4096, M = 8192, DM = 2048, INC = 5120, PW = 1024, HW_ = 1024, FF = 5632, FF2 = 11264, NH = 8, CH = 64, NCH = SEQ / CH;
constexpr int NUNIT = 2 * NH * NCH;
constexpr float ALPHA = 1.189207115002721f, LN_EPS = 1e-5f, RMS_EPS = 1e-6f;
constexpr size_t MiB = 1u << 20;
constexpr size_t WS_WDN = 1 * MiB, WS_WPOOL = 23 * MiB, WS_WIN = 24 * MiB, WS_WOUT = 44 * MiB, WS_WUP = 52 * MiB, WS_X1B = 96 * MiB;
constexpr size_t WS_XB = 128 * MiB  , WS_UP = 160 * MiB, WS_Q = 176 * MiB, WS_G = 192 * MiB, WS_V = 224 * MiB, WS_GT = 240 * MiB, WS_PL = 256 * MiB, WS_S = 272 * MiB, WS_DEC = 336 * MiB;
constexpr size_t WS_U = 128 * MiB  , WS_HH = 24 * MiB  ;
constexpr size_t WS_END = 337 * MiB;
constexpr int LDS_BYTES = 147456;

__device__ __forceinline__ unsigned pk2(float lo, float hi) { return pg8::cvt_pk_bf16(lo, hi); }
__device__ __forceinline__ float bf2f(unsigned short h) { return __uint_as_float((unsigned)h << 16); }
__device__ __forceinline__ float bflo(unsigned w) { return __uint_as_float(w << 16); }
__device__ __forceinline__ float bfhi(unsigned w) { return __uint_as_float(w & 0xffff0000u); }
__device__ __forceinline__ float wave_sum(float v) {
#pragma unroll
    for (int o = 1; o < 64; o <<= 1) v += __shfl_xor(v, o);
    return v;
}
__device__ __forceinline__ float expc(float x) { return __expf(fminf(x, 80.0f)); }

__device__ __forceinline__ void p0_transpose_item(const float* W, int K, int N, bf16* WT, int row_off, LAS float* scr, int item, int lane) {
    const int nblk = N / 32, kb = item / nblk, nb = item % nblk, k0 = 64 * kb, n0 = 32 * nb;
#pragma unroll 8
    for (int i = 0; i < 32; ++i) { const int kk = 2 * i + (lane >> 5); scr[kk * 33 + (lane & 31)] = W[(size_t)(k0 + kk) * N + n0 + (lane & 31)]; }
    asm volatile("s_waitcnt lgkmcnt(0)" ::: "memory");
    const int c = lane & 7;
#pragma unroll
    for (int j = 0; j < 4; ++j) { const int n = (lane >> 3) + 8 * j; const LAS float* s = scr + (8 * c) * 33 + n;
        u32x4 o; o.x = pk2(s[0 * 33], s[1 * 33]); o.y = pk2(s[2 * 33], s[3 * 33]); o.z = pk2(s[4 * 33], s[5 * 33]); o.w = pk2(s[6 * 33], s[7 * 33]);
        *(u32x4*)(WT + (size_t)(row_off + n0 + n) * K + k0 + 8 * c) = o; }
    asm volatile("s_waitcnt lgkmcnt(0)" ::: "memory");
}

__device__ __forceinline__ void ln_rows(const float* Y, float* Xo, bf16* Xb, const float* gam, const float* bet, int gw, int ngw, int lane) {
    for (int r = gw; r < M; r += ngw) {
        const f32x4* yr = (const f32x4*)(Y + (size_t)r * DM) + lane;
        f32x4 v[8]; float s = 0.f;
#pragma unroll
        for (int j = 0; j < 8; ++j) { v[j] = yr[64 * j]; s += (v[j].x + v[j].y) + (v[j].z + v[j].w); }
        const float mean = wave_sum(s) * (1.f / DM); float s2 = 0.f;
#pragma unroll
        for (int j = 0; j < 8; ++j) { v[j] = v[j] - mean; s2 += (v[j].x * v[j].x + v[j].y * v[j].y) + (v[j].z * v[j].z + v[j].w * v[j].w); }
        const float rstd = 1.0f / sqrtf(wave_sum(s2) * (1.f / DM) + LN_EPS);
        f32x4* xo = (f32x4*)(Xo + (size_t)r * DM) + lane;
        u32x2* xb = Xb ? (u32x2*)(Xb + (size_t)r * DM) + lane : nullptr;
#pragma unroll
        for (int j = 0; j < 8; ++j) {
            const f32x4 g4 = ((const f32x4*)gam)[lane + 64 * j], b4 = ((const f32x4*)bet)[lane + 64 * j];
            const f32x4 o = v[j] * rstd * g4 + b4;
            xo[64 * j] = o;
            if (Xb) { u32x2 w; w.x = pk2(o.x, o.y); w.y = pk2(o.z, o.w); xb[64 * j] = w; }
        }
    }
}

__device__ __forceinline__ void hgrn_pass1(LAS unsigned char* lds, const float* G, const bf16* V, float* S, float* DEC, int unit) {
    const int tid = threadIdx.x, lane = tid & 63, wid = tid >> 6, fr = lane & 15, fq = lane >> 4;
    const int bh = unit >> 6, n = unit & 63, b = bh >> 3, h = bh & 7;
    const size_t row0 = (size_t)b * SEQ + (size_t)n * CH; const int c0 = h * 128;
    LAS float* parts = (LAS float*)lds;
    LAS bf16* KT = (LAS bf16*)(lds + 2048);
    LAS bf16* VT = (LAS bf16*)(lds + 2048 + 128 * 144);
    const int k = tid & 127, qd = tid >> 7;
    float g[16], bb[16]; unsigned short vv[16];
#pragma unroll
    for (int i = 0; i < 16; ++i) g[i] = G[(row0 + 16 * qd + i) * 1024 + c0 + k];
#pragma unroll
    for (int i = 0; i < 16; ++i) vv[i] = V[(row0 + 16 * qd + i) * 1024 + c0 + k];
    float run = 0.f;
#pragma unroll
    for (int i = 0; i < 16; ++i) { run += g[i]; bb[i] = run; }
    parts[qd * 128 + k] = run;
    __syncthreads();
    float off = 0.f, tot = 0.f;
#pragma unroll
    for (int j = 0; j < 4; ++j) { const float p = parts[j * 128 + k]; if (j < qd) off += p; tot += p; }
    float kt[16];
#pragma unroll
    for (int i = 0; i < 16; ++i) kt[i] = (1.0f - __expf(g[i])) * expc(tot - (bb[i] + off));
    u32x4 w0, w1;
    w0.x = pk2(kt[0], kt[1]); w0.y = pk2(kt[2], kt[3]); w0.z = pk2(kt[4], kt[5]); w0.w = pk2(kt[6], kt[7]);
    w1.x = pk2(kt[8], kt[9]); w1.y = pk2(kt[10], kt[11]); w1.z = pk2(kt[12], kt[13]); w1.w = pk2(kt[14], kt[15]);
    *(LAS u32x4*)(KT + k * 72 + 16 * qd) = w0; *(LAS u32x4*)(KT + k * 72 + 16 * qd + 8) = w1;
    u32x4 x0, x1;
    x0.x = vv[0] | ((unsigned)vv[1] << 16); x0.y = vv[2] | ((unsigned)vv[3] << 16); x0.z = vv[4] | ((unsigned)vv[5] << 16); x0.w = vv[6] | ((unsigned)vv[7] << 16);
    x1.x = vv[8] | ((unsigned)vv[9] << 16); x1.y = vv[10] | ((unsigned)vv[11] << 16); x1.z = vv[12] | ((unsigned)vv[13] << 16); x1.w = vv[14] | ((unsigned)vv[15] << 16);
    *(LAS u32x4*)(VT + k * 72 + 16 * qd) = x0; *(LAS u32x4*)(VT + k * 72 + 16 * qd + 8) = x1;
    if (qd == 0) DEC[(size_t)unit * 128 + k] = __expf(tot);
    __syncthreads();
    bf16x8 a[2];
#pragma unroll
    for (int kk = 0; kk < 2; ++kk) a[kk] = *(const LAS bf16x8*)(KT + (16 * wid + fr) * 72 + kk * 32 + 8 * fq);
    float* Su = S + (size_t)unit * 16384;
#pragma unroll
    for (int vb = 0; vb < 8; ++vb) {
        f32x4 acc = {0.f, 0.f, 0.f, 0.f};
#pragma unroll
        for (int kk = 0; kk < 2; ++kk) { const bf16x8 bfr = *(const LAS bf16x8*)(VT + (16 * vb + fr) * 72 + kk * 32 + 8 * fq); acc = __builtin_amdgcn_mfma_f32_16x16x32_bf16(a[kk], bfr, acc, 0, 0, 0); }
        *(f32x4*)(Su + (size_t)(16 * vb + fr) * 128 + 16 * wid + 4 * fq) = acc;
    }
    __syncthreads();
}

__device__ __forceinline__ void hgrn_pass3(LAS unsigned char* lds, const float* G, const bf16* Q, const bf16* V, const bf16* GT, const float* S, const float* gnorm, bf16* MIX, int unit) {
    const int tid = threadIdx.x, lane = tid & 63, wid = tid >> 6, fr = lane & 15, fq = lane >> 4;
    const int bh = unit >> 6, n = unit & 63, b = bh >> 3, h = bh & 7;
    const size_t row0 = (size_t)b * SEQ + (size_t)n * CH; const int c0 = h * 128;
    LAS float* parts = (LAS float*)lds;
    LAS float* EM = (LAS float*)(lds + 2048);
    LAS bf16* QM = (LAS bf16*)(lds + 3072);
    LAS bf16* KM = (LAS bf16*)(lds + 20480);
    LAS bf16* VT = (LAS bf16*)(lds + 37888);
    LAS bf16* P = (LAS bf16*)(lds + 56320);
    LAS bf16* ST = (LAS bf16*)(lds + 65536);
    LAS float* O = (LAS float*)(lds + 65536);
    const int k = tid & 127, qd = tid >> 7;
    float g[16], bb[16]; unsigned short qq[16], vv[16];
#pragma unroll
    for (int i = 0; i < 16; ++i) g[i] = G[(row0 + 16 * qd + i) * 1024 + c0 + k];
#pragma unroll
    for (int i = 0; i < 16; ++i) qq[i] = Q[(row0 + 16 * qd + i) * 1024 + c0 + k];
#pragma unroll
    for (int i = 0; i < 16; ++i) vv[i] = V[(row0 + 16 * qd + i) * 1024 + c0 + k];
    float run = 0.f;
#pragma unroll
    for (int i = 0; i < 16; ++i) { run += g[i]; bb[i] = run; }
    parts[qd * 128 + k] = run;
    __syncthreads();
    float off = 0.f;
#pragma unroll
    for (int j = 0; j < 4; ++j) { const float p = parts[j * 128 + k]; if (j < qd) off += p; }
    const float mref = parts[k] + parts[128 + k];
#pragma unroll
    for (int i = 0; i < 16; ++i) {
        const float bf = bb[i] + off; const int t = 16 * qd + i;
        const float qm = bf2f(qq[i]) * expc(bf - mref), km = (1.0f - __expf(g[i])) * expc(mref - bf);
        QM[t * 136 + k] = (bf16)(pk2(qm, 0.f) & 0xffffu); KM[t * 136 + k] = (bf16)(pk2(km, 0.f) & 0xffffu);
    }
    u32x4 x0, x1;
    x0.x = vv[0] | ((unsigned)vv[1] << 16); x0.y = vv[2] | ((unsigned)vv[3] << 16); x0.z = vv[4] | ((unsigned)vv[5] << 16); x0.w = vv[6] | ((unsigned)vv[7] << 16);
    x1.x = vv[8] | ((unsigned)vv[9] << 16); x1.y = vv[10] | ((unsigned)vv[11] << 16); x1.z = vv[12] | ((unsigned)vv[13] << 16); x1.w = vv[14] | ((unsigned)vv[15] << 16);
    *(LAS u32x4*)(VT + k * 72 + 16 * qd) = x0; *(LAS u32x4*)(VT + k * 72 + 16 * qd + 8) = x1;
    if (qd == 0) EM[k] = __expf(mref);
    __syncthreads();
    const float* Su = S + (size_t)unit * 16384;
#pragma unroll
    for (int j = 0; j < 8; ++j) {
        const int idx = tid + NT * j, v = idx >> 5, k4 = (idx & 31) * 4;
        const f32x4 s = *(const f32x4*)(Su + v * 128 + k4); const f32x4 em = *(const LAS f32x4*)(EM + k4);
        u32x2 w; w.x = pk2(s.x * em.x, s.y * em.y); w.y = pk2(s.z * em.z, s.w * em.w);
        *(LAS u32x2*)(ST + v * 136 + k4) = w;
    }
    {
        const int tb = wid >> 1;
        bf16x8 aq[4];
#pragma unroll
        for (int kk = 0; kk < 4; ++kk) aq[kk] = *(const LAS bf16x8*)(QM + (16 * tb + fr) * 136 + kk * 32 + 8 * fq);
#pragma unroll
        for (int j = 0; j < 2; ++j) {
            const int sb = 2 * (wid & 1) + j;
            f32x4 acc = {0.f, 0.f, 0.f, 0.f};
            if (sb <= tb) {
#pragma unroll
                for (int kk = 0; kk < 4; ++kk) { const bf16x8 bk = *(const LAS bf16x8*)(KM + (16 * sb + fr) * 136 + kk * 32 + 8 * fq); acc = __builtin_amdgcn_mfma_f32_16x16x32_bf16(aq[kk], bk, acc, 0, 0, 0); }
            }
            const int s = 16 * sb + fr;
#pragma unroll
            for (int r = 0; r < 4; ++r) { const int t = 16 * tb + 4 * fq + r; const float pv = (s <= t) ? acc[r] : 0.f; P[t * 72 + s] = (bf16)(pk2(pv, 0.f) & 0xffffu); }
        }
    }
    __syncthreads();
    f32x4 oacc[4];
    {
        bf16x8 bs[4], bv[2];
#pragma unroll
        for (int kk = 0; kk < 4; ++kk) bs[kk] = *(const LAS bf16x8*)(ST + (16 * wid + fr) * 136 + kk * 32 + 8 * fq);
#pragma unroll
        for (int kk = 0; kk < 2; ++kk) bv[kk] = *(const LAS bf16x8*)(VT + (16 * wid + fr) * 72 + kk * 32 + 8 * fq);
#pragma unroll
        for (int tb = 0; tb < 4; ++tb) {
            f32x4 acc = {0.f, 0.f, 0.f, 0.f};
#pragma unroll
            for (int kk = 0; kk < 4; ++kk) { const bf16x8 aq = *(const LAS bf16x8*)(QM + (16 * tb + fr) * 136 + kk * 32 + 8 * fq); acc = __builtin_amdgcn_mfma_f32_16x16x32_bf16(aq, bs[kk], acc, 0, 0, 0); }
#pragma unroll
            for (int kk = 0; kk < 2; ++kk) { const bf16x8 ap = *(const LAS bf16x8*)(P + (16 * tb + fr) * 72 + kk * 32 + 8 * fq); acc = __builtin_amdgcn_mfma_f32_16x16x32_bf16(ap, bv[kk], acc, 0, 0, 0); }
            oacc[tb] = acc;
        }
    }
    __syncthreads();
#pragma unroll
    for (int tb = 0; tb < 4; ++tb)
#pragma unroll
        for (int r = 0; r < 4; ++r) O[(16 * tb + 4 * fq + r) * 132 + 16 * wid + fr] = oacc[tb][r];
    __syncthreads();
    {
        const int t = tid >> 3, seg = tid & 7;
        f32x4 o[4]; float ss = 0.f;
#pragma unroll
        for (int j = 0; j < 4; ++j) { o[j] = *(const LAS f32x4*)(O + t * 132 + 16 * seg + 4 * j); ss += (o[j].x * o[j].x + o[j].y * o[j].y) + (o[j].z * o[j].z + o[j].w * o[j].w); }
        ss += __shfl_xor(ss, 1); ss += __shfl_xor(ss, 2); ss += __shfl_xor(ss, 4);
        const float r = 1.0f / sqrtf(ss * (1.0f / 128.0f) + RMS_EPS);
        const int c = c0 + 16 * seg;
        const u32x4 g0 = *(const u32x4*)(GT + (row0 + t) * 1024 + c), g1 = *(const u32x4*)(GT + (row0 + t) * 1024 + c + 8);
        const unsigned gw[8] = {g0.x, g0.y, g0.z, g0.w, g1.x, g1.y, g1.z, g1.w};
        unsigned ow[8];
#pragma unroll
        for (int j = 0; j < 4; ++j) {
            const f32x4 gn = *(const f32x4*)(gnorm + c + 4 * j);
            const float y0 = o[j].x * r * gn.x * bflo(gw[2 * j]), y1 = o[j].y * r * gn.y * bfhi(gw[2 * j]);
            const float y2 = o[j].z * r * gn.z * bflo(gw[2 * j + 1]), y3 = o[j].w * r * gn.w * bfhi(gw[2 * j + 1]);
            ow[2 * j] = pk2(y0, y1); ow[2 * j + 1] = pk2(y2, y3);
        }
        bf16* dst = MIX + (row0 + t) * DM + 1024 + c;
        *(u32x4*)dst = (u32x4){ow[0], ow[1], ow[2], ow[3]}; *(u32x4*)(dst + 8) = (u32x4){ow[4], ow[5], ow[6], ow[7]};
    }
    __syncthreads();
}


#define XB_TMO      128
#define XB_XCNT(j)  (256  + 64 * (j))
#define XB_XSUB(j)  (1280 + 64 * (j))
#define XB_XGEN(j)  (2304 + 64 * (j))
#define XB_TOP      3328
#define XB_TOPGEN   3392
#define XCD_BAR_WORDS 3456
#define XB_SPIN_CAP (1u << 18)
__device__ __forceinline__ unsigned xb_ld(unsigned* p)              { return __hip_atomic_load(p, __ATOMIC_RELAXED, __HIP_MEMORY_SCOPE_AGENT); }
__device__ __forceinline__ unsigned xb_add(unsigned* p, unsigned v) { return __hip_atomic_fetch_add(p, v, __ATOMIC_RELAXED, __HIP_MEMORY_SCOPE_AGENT); }
__device__ __forceinline__ unsigned xb_xcc_id() { return (unsigned)__builtin_amdgcn_s_getreg((3 << 11) | 20) & 0xFu; }
#define XB_SPIN(cond, bar) do { unsigned _sp = 0; while (cond) { __builtin_amdgcn_s_sleep(1); \
    if ((++_sp & 255u) == 0u) { if (xb_ld(&(bar)[XB_TMO])) break; if (_sp > XB_SPIN_CAP) { atomicAdd(&(bar)[XB_TMO], 1u); break; } } } } while (0)
struct XcdBarrier { unsigned* bar; unsigned x; volatile LAS unsigned* st; };
__device__ __forceinline__ XcdBarrier xcd_barrier_post(unsigned* bar, volatile LAS unsigned* st) {
    XcdBarrier b; b.bar = bar; b.x = xb_xcc_id(); b.st = st;
    if (threadIdx.x == 0) (void)xb_add(&bar[XB_XCNT(b.x)], 1u);
    return b;
}
__device__ __forceinline__ void xcd_barrier_complete(unsigned* bar, unsigned x, unsigned& nloc, unsigned& nx) {
    const unsigned G = gridDim.x * gridDim.y * gridDim.z;
    unsigned sum, cnt, mine, sp = 0u;
    for (;;) {
        sum = 0u; cnt = 0u; mine = 0u;
#pragma unroll
        for (unsigned j = 0; j < 16; ++j) { const unsigned c = xb_ld(&bar[XB_XCNT(j)]); sum += c; cnt += (c > 0u) ? 1u : 0u; mine = (j == x) ? c : mine; }
        if (sum == G) break;
        __builtin_amdgcn_s_sleep(1);
        if ((++sp & 255u) == 0u) { if (xb_ld(&bar[XB_TMO])) break; if (sp > XB_SPIN_CAP) { atomicAdd(&bar[XB_TMO], 1u); break; } }
    }
    nloc = mine > 0u ? mine : 1u; nx = cnt > 0u ? cnt : 1u;
}
__device__ __forceinline__ void xcd_barrier(const XcdBarrier& b) {
    asm volatile("s_waitcnt vmcnt(0)" ::: "memory");
    __syncthreads();
    if (threadIdx.x == 0) {
        unsigned* bar = b.bar;
        __builtin_amdgcn_s_waitcnt(0);
        unsigned nloc = b.st[0], nx = b.st[1];
        if (nloc == 0u) { xcd_barrier_complete(bar, b.x, nloc, nx); b.st[0] = nloc; b.st[1] = nx; }
        const unsigned old = xb_add(&bar[XB_XSUB(b.x)], 1u);
        const unsigned gen = old / nloc;
        if (old + 1u == (gen + 1u) * nloc) {
            __builtin_amdgcn_fence(__ATOMIC_RELEASE, "agent");
            asm volatile("s_waitcnt vmcnt(0)" ::: "memory");
            const unsigned og = xb_add(&bar[XB_TOP], 1u);
            const unsigned tg = og / nx;
            if (og + 1u == (tg + 1u) * nx) xb_add(&bar[XB_TOPGEN], 1u);
            else XB_SPIN(xb_ld(&bar[XB_TOPGEN]) == tg, bar);
            __builtin_amdgcn_fence(__ATOMIC_ACQUIRE, "agent");
            xb_add(&bar[XB_XGEN(b.x)], 1u);
            asm volatile("s_waitcnt vmcnt(0)" ::: "memory");
        } else {
            XB_SPIN(xb_ld(&bar[XB_XGEN(b.x)]) == gen, bar);
            __builtin_amdgcn_fence(__ATOMIC_ACQUIRE, "agent");
            asm volatile("s_waitcnt vmcnt(0)" ::: "memory");
        }
    }
    __syncthreads();
}

struct Args { const float* in[16]; float* out; unsigned char* ws; };
__global__ void __launch_bounds__(NT, 2) fwd_mega(Args a) {
    extern __shared__ __attribute__((aligned(16))) unsigned char lds_raw[];
    LAS unsigned char* lds = (LAS unsigned char*)lds_raw;
    cg::grid_group grid = cg::this_grid();
    const int tid = threadIdx.x, lane = tid & 63, wave = __builtin_amdgcn_readfirstlane(tid >> 6);
    const int G_ = gridDim.x, bx = blockIdx.x;
    const int gw = bx * NWAVES + wave, ngw = G_ * NWAVES;
    const int gt = bx * NT + tid, ngt = G_ * NT;
    const float *x = a.in[0], *w_in = a.in[1], *pool_w = a.in[2], *pool_b = a.in[3], *pool_scale = a.in[4], *lbl = a.in[5], *gnorm = a.in[6], *w_out = a.in[7],
                *ln1_g = a.in[8], *ln1_b = a.in[9], *w_up = a.in[10], *conv_w = a.in[11], *conv_b = a.in[12], *w_down = a.in[13], *ln2_g = a.in[14], *ln2_b = a.in[15];
    unsigned char* ws = a.ws; float* out = a.out;
    bf16 *Wdn = (bf16*)(ws + WS_WDN), *Wpool = (bf16*)(ws + WS_WPOOL), *Win = (bf16*)(ws + WS_WIN), *Wout = (bf16*)(ws + WS_WOUT), *Wup = (bf16*)(ws + WS_WUP), *X1B = (bf16*)(ws + WS_X1B);
    bf16 *XB = (bf16*)(ws + WS_XB), *MIX = (bf16*)(ws + WS_XB), *UP = (bf16*)(ws + WS_UP), *Qb = (bf16*)(ws + WS_Q), *Vb = (bf16*)(ws + WS_V), *GT = (bf16*)(ws + WS_GT), *PL = (bf16*)(ws + WS_PL);
    float *Gf = (float*)(ws + WS_G), *Sst = (float*)(ws + WS_S), *DEC = (float*)(ws + WS_DEC);
    bf16 *U = (bf16*)(ws + WS_U), *HH = (bf16*)(ws + WS_HH);

    volatile LAS unsigned* MISC = (volatile LAS unsigned*)(lds + 131072 + 12288);
    if (tid < 16) MISC[tid] = 0u;
    unsigned* barw = (unsigned*)ws;
    if (bx == 0) for (int i = tid; i < XCD_BAR_WORDS; i += NT) __hip_atomic_store(barw + i, 0u, __ATOMIC_RELAXED, __HIP_MEMORY_SCOPE_AGENT);
    __syncthreads();
    {
        LAS float* scr = (LAS float*)(lds + wave * 16384);
        constexpr int I_IN = (DM / 64) * (INC / 32), I_OUT = (DM / 64) * (DM / 32), I_UP = (DM / 64) * (FF2 / 32), I_DN = (FF / 64) * (DM / 32), I_PL = (256 / 64) * (256 / 32);
        constexpr int NITEMS = I_IN + I_OUT + I_UP + I_DN + 4 * I_PL;
        for (int it = gw; it < NITEMS; it += ngw) {
            int r = it;
            if (r < I_IN) { p0_transpose_item(w_in, DM, INC, Win, 0, scr, r, lane); continue; } r -= I_IN;
            if (r < I_OUT) { p0_transpose_item(w_out, DM, DM, Wout, 0, scr, r, lane); continue; } r -= I_OUT;
            if (r < I_UP) { p0_transpose_item(w_up, DM, FF2, Wup, 0, scr, r, lane); continue; } r -= I_UP;
            if (r < I_DN) { p0_transpose_item(w_down, FF, DM, Wdn, 0, scr, r, lane); continue; } r -= I_DN;
            { const int gi = r / I_PL; p0_transpose_item(pool_w + (size_t)gi * 65536, 256, 256, Wpool, gi * 256, scr, r % I_PL, lane); }
        }
        for (int i = gt; i < M * DM / 8; i += ngt) {
            const f32x4 v0 = ((const f32x4*)x)[2 * i], v1 = ((const f32x4*)x)[2 * i + 1];
            ((u32x4*)XB)[i] = (u32x4){pk2(v0.x, v0.y), pk2(v0.z, v0.w), pk2(v1.x, v1.y), pk2(v1.z, v1.w)};
        }
    }
    grid.sync();
    const XcdBarrier xbar = xcd_barrier_post(barw, MISC);
    {
        pg8::Gemm g{XB, Win, M, INC, DM, DM, 0}; pg8::StaticOrder S; S.init(M, INC, G_, bx);
        pg8::EpiInProj E{UP, Qb, Vb, GT, Gf, lbl};
        pg8::gemm_phase<pg8::EpiInProj, pg8::StaticOrder, true, true>(lds, g, S, E);
    }
    xcd_barrier(xbar);
    {
        for (int it = gt; it < M * 128; it += ngt) {
            const int row = it >> 7, c8 = (it & 127) * 8, gi = c8 >> 8, w = 2 << gi, t = row & (SEQ - 1), nw = (t + 1 < w) ? t + 1 : w;
            float s[8] = {0.f, 0.f, 0.f, 0.f, 0.f, 0.f, 0.f, 0.f}; float u0[8];
            for (int j = 0; j < nw; ++j) {
                const u32x4 q = *(const u32x4*)(UP + (size_t)(row - j) * 1024 + c8);
                const float f[8] = {bflo(q.x), bfhi(q.x), bflo(q.y), bfhi(q.y), bflo(q.z), bfhi(q.z), bflo(q.w), bfhi(q.w)};
#pragma unroll
                for (int e = 0; e < 8; ++e) { s[e] += f[e]; if (j == 0) u0[e] = f[e]; }
            }
            const float inv = 1.0f / (float)nw;
            *(u32x4*)(PL + (size_t)row * 1024 + c8) = (u32x4){pk2(s[0] * inv - u0[0], s[1] * inv - u0[1]), pk2(s[2] * inv - u0[2], s[3] * inv - u0[3]),
                                                              pk2(s[4] * inv - u0[4], s[5] * inv - u0[5]), pk2(s[6] * inv - u0[6], s[7] * inv - u0[7])};
        }
        for (int u = bx; u < NUNIT; u += G_) hgrn_pass1(lds, Gf, Vb, Sst, DEC, u);
    }
    xcd_barrier(xbar);
    {
        for (int it = gt; it < 16 * 8192; it += ngt) {
            const int bh = it >> 13, e2 = it & 8191, k = (2 * e2) & 127;
            f32x2* p = (f32x2*)(Sst + (size_t)bh * 64 * 16384) + e2; const float* d = DEC + (size_t)bh * 64 * 128 + k;
            f32x2 run = {0.f, 0.f};
#pragma unroll 8
            for (int n = 0; n < NCH; ++n) { const f32x2 t = p[(size_t)n * 8192]; const f32x2 dd = *(const f32x2*)(d + n * 128); p[(size_t)n * 8192] = run; run = dd * run + t; }
        }
        pg8::Gemm g{PL, Wpool, M, PW, 256, PW, 256}; pg8::StaticOrder S; S.init(M, PW, G_, bx);
        pg8::EpiBf16 E{MIX, DM, pool_b, pool_scale};
        pg8::gemm_phase<pg8::EpiBf16, pg8::StaticOrder, true, true>(lds, g, S, E);
    }
    xcd_barrier(xbar);
    for (int u = bx; u < NUNIT; u += G_) hgrn_pass3(lds, Gf, Qb, Vb, GT, Sst, gnorm, MIX, u);
    xcd_barrier(xbar);
    {
        pg8::Gemm g{MIX, Wout, M, DM, DM, DM, 0}; pg8::StaticOrder S; S.init(M, DM, G_, bx);
        pg8::EpiResF32 E{x, out, DM, ALPHA};
        pg8::gemm_phase<pg8::EpiResF32, pg8::StaticOrder, true, true>(lds, g, S, E);
    }
    xcd_barrier(xbar);
    ln_rows(out, out, X1B, ln1_g, ln1_b, gw, ngw, lane);
    xcd_barrier(xbar);
    {
        pg8::Gemm g{X1B, Wup, M, FF2, DM, DM, 0}; pg8::StaticOrder S; S.init(M, FF2, G_, bx);
        pg8::EpiBf16 E{U, FF2, nullptr, nullptr};
        pg8::gemm_phase<pg8::EpiBf16, pg8::StaticOrder, true, true>(lds, g, S, E);
    }
    xcd_barrier(xbar);
    {
        constexpr int NCW = FF / 512, NSEG = M / 8;
        for (int wi = gw; wi < NCW * NSEG; wi += ngw) {
            const int cw = wi % NCW, seg = wi / NCW, c = (cw * 64 + lane) * 8, r0 = seg * 8, t0 = r0 & (SEQ - 1);
            float wg[3][8], wv[3][8], cbg[8], cbv[8];
#pragma unroll
            for (int j = 0; j < 3; ++j)
#pragma unroll
                for (int e = 0; e < 8; ++e) { wg[j][e] = conv_w[(size_t)j * FF2 + c + e]; wv[j][e] = conv_w[(size_t)j * FF2 + FF + c + e]; }
#pragma unroll
            for (int e = 0; e < 8; ++e) { cbg[e] = conv_b[c + e]; cbv[e] = conv_b[FF + c + e]; }
            float pg[2][8], pv[2][8];
#pragma unroll
            for (int j = 0; j < 2; ++j) {
                if (t0 - 2 + j >= 0) {
                    const u32x4 qg = *(const u32x4*)(U + (size_t)(r0 - 2 + j) * FF2 + c), qv = *(const u32x4*)(U + (size_t)(r0 - 2 + j) * FF2 + FF + c);
                    const float fg[8] = {bflo(qg.x), bfhi(qg.x), bflo(qg.y), bfhi(qg.y), bflo(qg.z), bfhi(qg.z), bflo(qg.w), bfhi(qg.w)};
                    const float fv[8] = {bflo(qv.x), bfhi(qv.x), bflo(qv.y), bfhi(qv.y), bflo(qv.z), bfhi(qv.z), bflo(qv.w), bfhi(qv.w)};
#pragma unroll
                    for (int e = 0; e < 8; ++e) { pg[j][e] = fg[e]; pv[j][e] = fv[e]; }
                } else {
#pragma unroll
                    for (int e = 0; e < 8; ++e) { pg[j][e] = 0.f; pv[j][e] = 0.f; }
                }
            }
#pragma unroll
            for (int i = 0; i < 8; ++i) {
                const u32x4 qg = *(const u32x4*)(U + (size_t)(r0 + i) * FF2 + c), qv = *(const u32x4*)(U + (size_t)(r0 + i) * FF2 + FF + c);
                const float fg[8] = {bflo(qg.x), bfhi(qg.x), bflo(qg.y), bfhi(qg.y), bflo(qg.z), bfhi(qg.z), bflo(qg.w), bfhi(qg.w)};
                const float fv[8] = {bflo(qv.x), bfhi(qv.x), bflo(qv.y), bfhi(qv.y), bflo(qv.z), bfhi(qv.z), bflo(qv.w), bfhi(qv.w)};
                float hv[8];
#pragma unroll
                for (int e = 0; e < 8; ++e) {
                    const float gc = cbg[e] + wg[0][e] * pg[0][e] + wg[1][e] * pg[1][e] + wg[2][e] * fg[e];
                    const float vc = cbv[e] + wv[0][e] * pv[0][e] + wv[1][e] * pv[1][e] + wv[2][e] * fv[e];
                    hv[e] = gc / (1.0f + __expf(-gc)) * vc;
                    pg[0][e] = pg[1][e]; pg[1][e] = fg[e]; pv[0][e] = pv[1][e]; pv[1][e] = fv[e];
                }
                *(u32x4*)(HH + (size_t)(r0 + i) * FF + c) = (u32x4){pk2(hv[0], hv[1]), pk2(hv[2], hv[3]), pk2(hv[4], hv[5]), pk2(hv[6], hv[7])};
            }
        }
    }
    xcd_barrier(xbar);
    {
        pg8::Gemm g{HH, Wdn, M, DM, FF, FF, 0}; pg8::StaticOrder S; S.init(M, DM, G_, bx);
        pg8::EpiResF32 E{out, out, DM, ALPHA};
        pg8::gemm_phase<pg8::EpiResF32, pg8::StaticOrder, true, true>(lds, g, S, E);
    }
    xcd_barrier(xbar);
    ln_rows(out, out, nullptr, ln2_g, ln2_b, gw, ngw, lane);
}

extern "C" void kernel_launch(void* const* d_in, const int* in_sizes, int n_in, void* d_out, int out_size, void* d_ws, size_t ws_size, hipStream_t stream) {
    static int grid = 0;
    if (grid == 0) {
        if (n_in != 16 || in_sizes[0] != M * DM || out_size != M * DM || ws_size < WS_END) { fprintf(stderr, "kernel_launch: unexpected shapes/ws (n_in %d, ws %zu)\n", n_in, ws_size); grid = -1; return; }
        int dev = 0, cus = 0, per_cu = 0;
        hipGetDevice(&dev); hipDeviceGetAttribute(&cus, hipDeviceAttributeMultiprocessorCount, dev);
        hipFuncSetAttribute((const void*)fwd_mega, hipFuncAttributeMaxDynamicSharedMemorySize, LDS_BYTES);
        hipOccupancyMaxActiveBlocksPerMultiprocessor(&per_cu, (const void*)fwd_mega, NT, LDS_BYTES);
        if (per_cu < 1) { fprintf(stderr, "kernel_launch: occupancy query says %d blocks/CU\n", per_cu); per_cu = 1; }
        if (per_cu > 1) per_cu = 1;
        grid = cus * per_cu;
    }
    if (grid < 0) return;
    Args a{};
    for (int i = 0; i < 16; ++i) a.in[i] = (const float*)d_in[i];
    a.out = (float*)d_out; a.ws = (unsigned char*)d_ws;
    void* args[] = {&a};
    hipError_t e = hipLaunchCooperativeKernel((const void*)fwd_mega, dim3(grid), dim3(NT), args, LDS_BYTES, stream);
    if (e != hipSuccess) fprintf(stderr, "cooperative launch failed: %s (grid %d)\n", hipGetErrorString(e), grid);
}
```
